# Optimizing an MI355X kernel written in HIP

```python
import math
import jax, jax.numpy as jnp
from jax import lax
import numpy as np

D_MODEL = 1024
BATCH = 16
SEQ = 4096
DEPTH = 1

CTX_LEN = 256
GRID_W = 64
MLA_HEADS = 8
NOPE_DIM = 64
ROPE_DIM = 32
V_DIM = 64
QK_DIM = NOPE_DIM + ROPE_DIM
Q_LORA = 256
KV_LORA = 128
MLA_WIDTH = MLA_HEADS * V_DIM
F_GROUPS = 4
F_GROUP_DIM = 128
F_WIDTH = F_GROUPS * F_GROUP_DIM
D_MIX = MLA_WIDTH + F_WIDTH
IN_SPLITS = (Q_LORA, KV_LORA, ROPE_DIM, MLA_WIDTH, F_WIDTH, F_WIDTH)
D_IN = sum(IN_SPLITS)
ROPE_BASE = 10000.0
Q_BLOCK = 128
LN_EPS = 1e-6
DEEPNORM_ALPHA = (2.0 * DEPTH) ** 0.25
DEEPNORM_BETA = (8.0 * DEPTH) ** -0.25

kernel_name = "hybrid_mla_fnet_prefix_block"


def _layer_norm(x, g=None, b=None):
    xf = x.astype(jnp.float32)
    mu = jnp.mean(xf, axis=-1, keepdims=True)
    var = jnp.mean(jnp.square(xf - mu), axis=-1, keepdims=True)
    y = (xf - mu) * lax.rsqrt(var + LN_EPS)
    if g is not None:
        y = y * g.astype(jnp.float32) + b.astype(jnp.float32)
    return y.astype(x.dtype)


def _rms_norm(x, g):
    xf = x.astype(jnp.float32)
    y = xf * lax.rsqrt(jnp.mean(jnp.square(xf), axis=-1, keepdims=True) + LN_EPS)
    return (y * g.astype(jnp.float32)).astype(x.dtype)


def _modulation(cvec, w_ada, b_ada):
    m = jax.nn.silu(cvec) @ w_ada + b_ada
    return jnp.split(m, 3, axis=-1)


def _axial_rope_tables(n_tokens, dtype):
    n_rows = n_tokens // GRID_W
    rows, cols = jnp.meshgrid(jnp.arange(n_rows), jnp.arange(GRID_W), indexing="ij")
    rows = rows.reshape(-1).astype(jnp.float32)
    cols = cols.reshape(-1).astype(jnp.float32)
    axis_dim = ROPE_DIM // 2
    inv_freq = ROPE_BASE ** (-jnp.arange(0, axis_dim, 2, dtype=jnp.float32) / axis_dim)
    ang = jnp.concatenate([rows[:, None] * inv_freq, cols[:, None] * inv_freq], axis=-1)
    ang = jnp.concatenate([ang, ang], axis=-1)
    return jnp.cos(ang).astype(dtype), jnp.sin(ang).astype(dtype)


def _apply_rope(x, cos, sin):
    half = x.shape[-1] // 2
    rot = jnp.concatenate([-x[..., half:], x[..., :half]], axis=-1)
    return x * cos + rot * sin


def _split_proj(h, w_in, b_in):
    proj = h @ w_in + b_in
    idx = [int(v) for v in np.cumsum(IN_SPLITS)[:-1]]
    return jnp.split(proj, idx, axis=-1)


def _mla_q(q_lat, q_norm_g, w_q_up):
    b, t, _ = q_lat.shape
    q = (_rms_norm(q_lat, q_norm_g) @ w_q_up).reshape(b, t, MLA_HEADS, QK_DIM)
    return q[..., :NOPE_DIM], q[..., NOPE_DIM:]


def _mla_kv(c_kv, kv_norm_g, w_kv_up):
    b, t, _ = c_kv.shape
    kv = (_rms_norm(c_kv, kv_norm_g) @ w_kv_up).reshape(b, t, MLA_HEADS, NOPE_DIM + V_DIM)
    return kv[..., :NOPE_DIM], kv[..., NOPE_DIM:]


def _assemble_k(k_nope, k_rope):
    b, t, h, _ = k_nope.shape
    return jnp.concatenate([k_nope, jnp.broadcast_to(k_rope[:, :, None, :], (b, t, h, ROPE_DIM))], axis=-1)


def _softmax_attend(q, k, v):
    s = jnp.einsum("bqhd,bkhd->bhqk", q, k).astype(jnp.float32) * (1.0 / math.sqrt(QK_DIM))
    p = jax.nn.softmax(s, axis=-1).astype(v.dtype)
    return jnp.einsum("bhqk,bkhv->bqhv", p, v)


def _latent_attention(q, k_lat, v_lat, k_ctx, v_ctx):
    b, s, h, d = q.shape
    k = jnp.concatenate([k_ctx, k_lat], axis=1)
    v = jnp.concatenate([v_ctx, v_lat], axis=1)
    qb = q.reshape(b, s // Q_BLOCK, Q_BLOCK, h, d).transpose(1, 0, 2, 3, 4)
    o = lax.map(lambda qi: _softmax_attend(qi, k, v), qb)
    return o.transpose(1, 0, 2, 3, 4).reshape(b, s, h * V_DIM)


def _fourier_mix(u, w_fourier, b_fourier):
    b, t, _ = u.shape
    ug = u.reshape(b, t, F_GROUPS, F_GROUP_DIM).astype(jnp.float32)
    z = jnp.fft.fft2(ug, axes=(1, 3), norm="ortho").real.astype(u.dtype).reshape(b, t, F_WIDTH)
    return z @ w_fourier + b_fourier


def _merge_out(attn, four, g_mla, g_f, w_out, b_out):
    y = jnp.concatenate([attn * jax.nn.silu(g_mla), four * jax.nn.silu(g_f)], axis=-1)
    return y @ w_out + b_out


def setup_inputs(seed: int = 0) -> dict:
    key = jax.random.key(seed)
    ks = jax.random.split(key, 20)
    f32 = jnp.float32
    nrm = lambda k, shape, s: jax.random.normal(k, shape, f32) * s
    return {
        "x": nrm(ks[0], (BATCH, SEQ, D_MODEL), 1.0),
        "c": nrm(ks[1], (BATCH, D_MODEL), 1.0),
        "ctx": nrm(ks[2], (BATCH, CTX_LEN, D_MODEL), 1.0),
        "c_ctx": nrm(ks[3], (D_MODEL,), 1.0),
        "w_ada": nrm(ks[4], (DEPTH, D_MODEL, 3 * D_MODEL), 0.5 * D_MODEL ** -0.5),
        "b_ada": nrm(ks[5], (DEPTH, 3 * D_MODEL), 0.02),
        "w_in": nrm(ks[6], (DEPTH, D_MODEL, D_IN), D_MODEL ** -0.5),
        "b_in": nrm(ks[7], (DEPTH, D_IN), 0.02),
        "q_norm_g": 1.0 + nrm(ks[8], (DEPTH, Q_LORA), 0.02),
        "w_q_up": nrm(ks[9], (DEPTH, Q_LORA, MLA_HEADS * QK_DIM), Q_LORA ** -0.5),
        "kv_norm_g": 1.0 + nrm(ks[10], (DEPTH, KV_LORA), 0.02),
        "w_kv_up": nrm(ks[11], (DEPTH, KV_LORA, MLA_HEADS * (NOPE_DIM + V_DIM)), KV_LORA ** -0.5),
        "w_fourier": nrm(ks[12], (DEPTH, F_WIDTH, F_WIDTH), F_WIDTH ** -0.5),
        "b_fourier": nrm(ks[13], (DEPTH, F_WIDTH), 0.02),
        "w_out": nrm(ks[14], (DEPTH, D_MIX, D_MODEL), DEEPNORM_BETA * D_MIX ** -0.5),
        "b_out": nrm(ks[15], (DEPTH, D_MODEL), 0.02),
        "post_ln_g": 1.0 + nrm(ks[16], (DEPTH, D_MODEL), 0.02),
        "post_ln_b": nrm(ks[17], (DEPTH, D_MODEL), 0.02),
    }


def reference(x, c, ctx, c_ctx, w_ada, b_ada, w_in, b_in, q_norm_g, w_q_up, kv_norm_g,
              w_kv_up, w_fourier, b_fourier, w_out, b_out, post_ln_g, post_ln_b):
    seq = x.shape[1]
    cos, sin = _axial_rope_tables(seq, x.dtype)
    cos_q, sin_q = cos[None, :, None, :], sin[None, :, None, :]
    cos_k, sin_k = cos[None], sin[None]
    for l in range(DEPTH):
        shift_x, scale_x, gate_x = _modulation(c, w_ada[l], b_ada[l])
        shift_c, scale_c, gate_c = _modulation(c_ctx, w_ada[l], b_ada[l])

        h_c = _layer_norm(ctx) * (1.0 + scale_c) + shift_c
        qlat_c, ckv_c, krope_c, gmla_c, fin_c, gf_c = _split_proj(h_c, w_in[l], b_in[l])
        knope_c, v_c = _mla_kv(ckv_c, kv_norm_g[l], w_kv_up[l])
        k_c = _assemble_k(knope_c, krope_c)

        h_x = _layer_norm(x) * (1.0 + scale_x[:, None, :]) + shift_x[:, None, :]
        qlat_x, ckv_x, krope_x, gmla_x, fin_x, gf_x = _split_proj(h_x, w_in[l], b_in[l])
        qnope_x, qrope_x = _mla_q(qlat_x, q_norm_g[l], w_q_up[l])
        q_x = jnp.concatenate([qnope_x, _apply_rope(qrope_x, cos_q, sin_q)], axis=-1)
        knope_x, v_x = _mla_kv(ckv_x, kv_norm_g[l], w_kv_up[l])
        k_x = _assemble_k(knope_x, _apply_rope(krope_x, cos_k, sin_k))
        attn_x = _latent_attention(q_x, k_x, v_x, k_c, v_c)
        four_x = _fourier_mix(fin_x, w_fourier[l], b_fourier[l])
        y_x = _merge_out(attn_x, four_x, gmla_x, gf_x, w_out[l], b_out[l])
        x_new = _layer_norm(DEEPNORM_ALPHA * x + gate_x[:, None, :] * y_x, post_ln_g[l], post_ln_b[l])

        if l + 1 < DEPTH:
            qnope_c, qrope_c = _mla_q(qlat_c, q_norm_g[l], w_q_up[l])
            q_c = jnp.concatenate([qnope_c, qrope_c], axis=-1)
            b, t, _ = ctx.shape
            attn_c = _softmax_attend(q_c, k_c, v_c).reshape(b, t, MLA_WIDTH)
            four_c = _fourier_mix(fin_c, w_fourier[l], b_fourier[l])
            y_c = _merge_out(attn_c, four_c, gmla_c, gf_c, w_out[l], b_out[l])
            ctx = _layer_norm(DEEPNORM_ALPHA * ctx + gate_c * y_c, post_ln_g[l], post_ln_b[l])
        x = x_new
    return x
```

```cpp
#include <hip/hip_runtime.h>
#include <hip/hip_cooperative_groups.h>
#include <cstdio>
#include <cstdint>
namespace cg = cooperative_groups;

#define LAS __attribute__((address_space(3)))
typedef unsigned short bf16_t;
typedef short bf16x8 __attribute__((ext_vector_type(8)));
typedef short s16x4 __attribute__((ext_vector_type(4)));
typedef float f32x4 __attribute__((ext_vector_type(4)));
typedef float f32x16 __attribute__((ext_vector_type(16)));
typedef unsigned u32x4 __attribute__((ext_vector_type(4)));
typedef float f32x2_t __attribute__((ext_vector_type(2)));
typedef __bf16 bf16x2_t __attribute__((ext_vector_type(2)));

constexpr int NTHR = 512;
constexpr int LDS_BYTES = 147456;
constexpr int DM = 1024, BATCH = 16, SEQ = 4096, CTX = 256, NLAT = BATCH * SEQ  , NCTX = BATCH * CTX  , NROW = NLAT + NCTX  ;
constexpr int SKV = CTX + SEQ;
constexpr int NH = 8, DQK = 96, DV = 64, QW = NH * DQK  , VW = NH * DV  ;
constexpr float LN_EPS = 1e-6f;
constexpr float ALPHA = 1.189207115002721f;
constexpr float C2 = 1.4426950408889634f * 0.10206207261596577f;
constexpr float FNORM = 0.0013810679320049757f;

constexpr size_t MiB = 1u << 20;
constexpr size_t WS_MOD = 1 * MiB;
constexpr size_t WS_ROPEC = 2 * MiB, WS_ROPES = 2 * MiB + 262144;
constexpr size_t WS_TWC = 2 * MiB + 524288, WS_TWS = WS_TWC + 16384;
constexpr size_t WS_BIN2 = WS_TWS + 16384;
constexpr size_t WS_WIN = 4 * MiB;
constexpr size_t WS_WO = 8 * MiB;
constexpr size_t WS_WQ = 10 * MiB;
constexpr size_t WS_WKV = 10 * MiB + 524288;
constexpr size_t WS_WF = 11 * MiB;
constexpr size_t WS_FC = 11 * MiB + 524288;
constexpr size_t WS_G1 = WS_FC + 65536, WS_G2 = WS_G1 + 65536;
constexpr size_t WS_QSS = 12 * MiB;
constexpr size_t WS_KSS = 13 * MiB;
constexpr size_t WS_XN = 16 * MiB;
constexpr size_t WS_X = WS_XN;
constexpr size_t WS_QLAT = 152 * MiB;
constexpr size_t WS_CKV = 184 * MiB;
constexpr size_t WS_SGM = 202 * MiB;
constexpr size_t WS_FIN = 266 * MiB;
constexpr size_t WS_SGF = 330 * MiB;
constexpr size_t WS_Q = 394 * MiB;
constexpr size_t WS_K = 490 * MiB;
constexpr size_t WS_V = 592 * MiB;
constexpr size_t WS_Y2 = 660 * MiB;
constexpr size_t WS_Z = 788 * MiB;
constexpr size_t WS_YMIX = 852 * MiB;
constexpr size_t WS_END = 980 * MiB;
static_assert(WS_SGF - WS_FIN == WS_FIN - WS_SGM, "SGM|FIN|SGF equally spaced");

__device__ __forceinline__ float wave_sum(float v) {
#pragma unroll
    for (int o = 1; o < 64; o <<= 1) v += __shfl_xor(v, o);
    return v;
}
__device__ __forceinline__ unsigned cvtpk(float lo, float hi) { f32x2_t v = {lo, hi}; bf16x2_t b = __builtin_convertvector(v, bf16x2_t); return __builtin_bit_cast(unsigned, b); }
__device__ __forceinline__ u32x4 pack8(const f32x4& a, const f32x4& b) { u32x4 w; w.x = cvtpk(a[0], a[1]); w.y = cvtpk(a[2], a[3]); w.z = cvtpk(b[0], b[1]); w.w = cvtpk(b[2], b[3]); return w; }
__device__ __forceinline__ float bf_lo(unsigned u) { return __uint_as_float(u << 16); }
__device__ __forceinline__ float bf_hi(unsigned u) { return __uint_as_float(u & 0xffff0000u); }
__device__ __forceinline__ float silu_f(float v) { return v * __builtin_amdgcn_rcpf(1.f + __expf(-v)); }
__device__ __forceinline__ f32x4 silu4(const f32x4& v) { return (f32x4){silu_f(v[0]), silu_f(v[1]), silu_f(v[2]), silu_f(v[3])}; }

namespace pg8 {
constexpr int BM = 256, BK = 64, HALF = 128, HTB = HALF * BK * 2, STAGE_BYTES = 8 * HTB, NXCD = 8, WGM = 8;
__device__ __forceinline__ int lds_byte(int r, int c) { const int st = (r >> 4) * 2 + (c >> 5), rr = r & 15, cc = c & 31, ob = rr * 64 + cc * 2; return st * 1024 + (ob ^ (((ob >> 9) & 1) << 5)); }
__device__ __forceinline__ void stage_rc(int b, int& R, int& C) { const int st = b / 1024, sb = b % 1024, swz = sb ^ (((sb >> 9) & 1) << 5); R = (st >> 1) * 16 + swz / 64; C = (st & 1) * 32 + (swz % 64) / 2; }
__device__ __forceinline__ int perm32(int rho) { const int n = rho >> 4, i = rho & 15; return 8 * (i >> 2) + 4 * n + (i & 3); }
struct Unit { int pm, pn; };

struct GridOrder {
    int nM, nN, nwg, G, c, extra, extra_pn;
    __device__ void init(int nM_, int nN_, int G_, int c_, int extra_ = 0, int extra_pn_ = 0) { nM = nM_; nN = nN_; nwg = nM * nN; G = G_; c = c_; extra = extra_; extra_pn = extra_pn_; }
    __device__ bool next(int i, Unit& u) const {
        const long L = (long)i * G + c;
        if (L >= nwg) { if (L < nwg + extra) { u.pm = nM + (int)(L - nwg); u.pn = extra_pn; return true; } return false; }
        int wgid = (int)L; { const int q = nwg / NXCD, r = nwg % NXCD, xcd = wgid % NXCD, off = wgid / NXCD; wgid = (xcd < r ? xcd * (q + 1) : r * (q + 1) + (xcd - r) * q) + off; }
        const int nig = WGM * nN, gid = wgid / nig, fm = gid * WGM, gsz = (nM - fm) < WGM ? (nM - fm) : WGM;
        u.pm = fm + ((wgid % nig) % gsz); u.pn = (wgid % nig) / gsz; return true;
    }
};
struct LinOrder {
    int n, G, c;
    __device__ void init(int n_, int G_, int c_) { n = n_; G = G_; c = c_; }
    __device__ bool next(int i, Unit& u) const { const long L = (long)i * G + c; if (L >= n) return false; u.pm = 0; u.pn = (int)L; return true; }
};

struct ProbRM {
    const bf16_t* A; const bf16_t* Bt; int lda, ldb, nt;
    __device__ __forceinline__ unsigned offA(int R, int C) const { return (unsigned)(R * lda + C) * 2u; }
    __device__ __forceinline__ unsigned offB(int R, int C) const { return (unsigned)(R * ldb + C) * 2u; }
    __device__ __forceinline__ size_t hstepA() const { return (size_t)HALF * lda * 2; }
    __device__ __forceinline__ size_t hstepB() const { return (size_t)HALF * ldb * 2; }
    __device__ __forceinline__ const char* baseA(const Unit& u) const { return (const char*)A + (size_t)u.pm * BM * lda * 2; }
    __device__ __forceinline__ const char* baseB(const Unit& u) const { return (const char*)Bt + (size_t)u.pn * BM * ldb * 2; }
};
struct ProbF0 {
    const bf16_t* A; const bf16_t* FIN; int nt;
    __device__ __forceinline__ unsigned offA(int R, int C) const { return (unsigned)(R * 128 + C) * 2u; }
    __device__ __forceinline__ unsigned offB(int R, int C) const { return (unsigned)((64 * (R & 63) + (R >> 6)) * 512 + C) * 2u; }
    __device__ __forceinline__ size_t hstepA() const { return (size_t)HALF * 128 * 2; }
    __device__ __forceinline__ size_t hstepB() const { return (size_t)2 * 512 * 2; }
    __device__ __forceinline__ const char* baseA(const Unit&) const { return (const char*)A; }
    __device__ __forceinline__ const char* baseB(const Unit& u) const { const int bg = u.pn >> 4, bgrp = u.pn & 15, batch = bg >> 2, g = bg & 3; return (const char*)FIN + ((size_t)(batch * 4096 + 4 * bgrp) * 512 + 128 * g) * 2; }
};

template <class Prob, class Epi, class Sched>
__device__ __forceinline__ void gemm_phase(LAS unsigned char* lds, const Prob& P, const Sched& S, const Epi& E) {
    int tid_ = threadIdx.x; asm volatile("" : "+v"(tid_));
    const int tid = tid_, wid = __builtin_amdgcn_readfirstlane(tid >> 6), lane = tid & 63, wr = wid >> 2, wc = wid & 3, fr = lane & 15, fq = lane >> 4;
    const int nt = P.nt;
    unsigned voffA[2], voffB[2];
#pragma unroll
    for (int i = 0; i < 2; ++i) { int R, C; stage_rc(tid * 16 + i * 8192, R, C); const int Rb = Epi::PERM ? ((R & ~31) + perm32(R & 31)) : R;
        voffA[i] = P.offA(R, C); voffB[i] = P.offB(Rb, C); }
    const size_t kstep = (size_t)(BK * 2);
    const size_t hstepA = P.hstepA(), hstepB = P.hstepB();
    const unsigned ldsw = (unsigned)wid * 1024u;
    const int aoff = lds_byte(wr * 64 + fr, fq * 8), boff = lds_byte(wc * 32 + fr, fq * 8);
#define PG8_SA(b, h) (((b) * 2 + (h)) * HTB)
#define PG8_SB(b, h) ((4 + (b) * 2 + (h)) * HTB)
#define PG8_STAGE(bufoff, gbase, voff) do { _Pragma("unroll") for (int _i = 0; _i < 2; ++_i) \
        __builtin_amdgcn_global_load_lds((const unsigned*)((const char*)(gbase) + (voff)[_i]), (LAS unsigned*)(lds + (bufoff) + ldsw + _i * 8192), 16, 0, 0); } while (0)
#define PG8_LDA(dst, b, h) do { _Pragma("unroll") for (int m = 0; m < 4; ++m) _Pragma("unroll") for (int k = 0; k < 2; ++k) dst[m][k] = *(const LAS bf16x8*)(lds + PG8_SA(b, h) + aoff + m * 2048 + k * 1024); } while (0)
#define PG8_LDB(dst, b, h) do { _Pragma("unroll") for (int n = 0; n < 2; ++n) _Pragma("unroll") for (int k = 0; k < 2; ++k) dst[n][k] = *(const LAS bf16x8*)(lds + PG8_SB(b, h) + boff + n * 2048 + k * 1024); } while (0)
#define PG8_MMA(ai, bj, At, Bt) do { __builtin_amdgcn_s_setprio(1); _Pragma("unroll") for (int m = 0; m < 4; ++m) _Pragma("unroll") for (int n = 0; n < 2; ++n) _Pragma("unroll") for (int k = 0; k < 2; ++k) \
        acc[ai][bj][m][n] = __builtin_amdgcn_mfma_f32_16x16x32_bf16(Bt[n][k], At[m][k], acc[ai][bj][m][n], 0, 0, 0); __builtin_amdgcn_s_setprio(0); } while (0)
#define PG8_WAIT_V(n) asm volatile("s_waitcnt vmcnt(" #n ")" ::: "memory")
#define PG8_WAIT_L(n) asm volatile("s_waitcnt lgkmcnt(" #n ")" ::: "memory")
#define PG8_BAR __builtin_amdgcn_s_barrier()
#define PG8_SCHED __builtin_amdgcn_sched_barrier(0)
    Unit cur, nxt; int ui = 0;
    if (!S.next(0, cur)) return;
    f32x4 acc[2][2][4][2];
#pragma unroll
    for (int a = 0; a < 2; ++a)
#pragma unroll
        for (int b = 0; b < 2; ++b)
#pragma unroll
            for (int m = 0; m < 4; ++m)
#pragma unroll
                for (int n = 0; n < 2; ++n) acc[a][b][m][n] = (f32x4){0.f, 0.f, 0.f, 0.f};
    bf16x8 At[4][2], B0[2][2], B1[2][2];
    const char* cA = P.baseA(cur); const char* cB = P.baseB(cur);
    PG8_STAGE(PG8_SB(0, 0), cB, voffB); PG8_STAGE(PG8_SB(0, 1), cB + hstepB, voffB); PG8_STAGE(PG8_SA(0, 0), cA, voffA); PG8_STAGE(PG8_SA(0, 1), cA + hstepA, voffA);
    if (wr == 1) PG8_BAR;
    PG8_WAIT_V(2); PG8_BAR;
    PG8_STAGE(PG8_SB(1, 0), cB + kstep, voffB); PG8_STAGE(PG8_SA(1, 0), cA + kstep, voffA); PG8_STAGE(PG8_SB(1, 1), cB + hstepB + kstep, voffB);
    PG8_WAIT_V(6); PG8_BAR;
    for (;;) {
        const bool has_next = S.next(ui + 1, nxt);
        const char* nA = has_next ? P.baseA(nxt) : cA; const char* nB = has_next ? P.baseB(nxt) : cB;
        for (int t = 0; t < nt; t += 2) {
            const bool last = (t == nt - 2);
            const char* a1 = cA + (size_t)(t + 1) * kstep;
            const char* a2 = last ? nA : cA + (size_t)(t + 2) * kstep; const char* b2 = last ? nB : cB + (size_t)(t + 2) * kstep;
            const char* a3 = a2 + kstep; const char* b3 = b2 + kstep;
            asm volatile("" : "+s"(a1), "+s"(a2), "+s"(b2), "+s"(a3), "+s"(b3));
            PG8_LDB(B0, 0, 0); PG8_LDB(B1, 0, 1); PG8_SCHED; PG8_LDA(At, 0, 0); PG8_STAGE(PG8_SA(1, 1), a1 + hstepA, voffA);
            PG8_WAIT_V(8); PG8_WAIT_L(0); PG8_BAR; PG8_MMA(0, 0, At, B0); PG8_MMA(0, 1, At, B1); PG8_BAR; PG8_SCHED;
            PG8_LDA(At, 0, 1); PG8_STAGE(PG8_SB(0, 0), b2, voffB); PG8_STAGE(PG8_SB(0, 1), b2 + hstepB, voffB); PG8_STAGE(PG8_SA(0, 0), a2, voffA);
            PG8_WAIT_V(8); PG8_WAIT_L(0); PG8_BAR; PG8_MMA(1, 0, At, B0); PG8_MMA(1, 1, At, B1); PG8_BAR; PG8_SCHED;
            PG8_LDB(B0, 1, 0); PG8_LDB(B1, 1, 1); PG8_SCHED; PG8_LDA(At, 1, 0); PG8_STAGE(PG8_SA(0, 1), a2 + hstepA, voffA);
            PG8_WAIT_V(8); PG8_WAIT_L(0); PG8_BAR; PG8_MMA(0, 0, At, B0); PG8_MMA(0, 1, At, B1); PG8_BAR; PG8_SCHED;
            PG8_LDA(At, 1, 1); PG8_STAGE(PG8_SB(1, 0), b3, voffB); PG8_STAGE(PG8_SB(1, 1), b3 + hstepB, voffB); PG8_STAGE(PG8_SA(1, 0), a3, voffA);
            PG8_WAIT_V(8); PG8_WAIT_L(0); PG8_BAR; PG8_MMA(1, 0, At, B0); PG8_MMA(1, 1, At, B1); PG8_BAR; PG8_SCHED;
        }
        if (wr == 0) PG8_BAR;
        E(acc, cur, wr, wc, fr, fq);
        if (!has_next) break;
#pragma unroll
        for (int a = 0; a < 2; ++a)
#pragma unroll
            for (int b = 0; b < 2; ++b)
#pragma unroll
                for (int m = 0; m < 4; ++m)
#pragma unroll
                    for (int n = 0; n < 2; ++n) acc[a][b][m][n] = (f32x4){0.f, 0.f, 0.f, 0.f};
        cur = nxt; cA = nA; cB = nB; ++ui;
        if (wr == 1) PG8_BAR;
    }
    PG8_WAIT_V(0);
    PG8_BAR;
#undef PG8_SA
#undef PG8_SB
#undef PG8_STAGE
#undef PG8_LDA
#undef PG8_LDB
#undef PG8_MMA
#undef PG8_WAIT_V
#undef PG8_WAIT_L
#undef PG8_BAR
#undef PG8_SCHED
}
}
using pg8::Unit;
typedef const f32x4 (&AccRef)[2][2][4][2];

template <class T> __device__ __forceinline__ T& wsat(unsigned char* ws, unsigned off) { return *(T*)(ws + (size_t)off); }
static_assert(WS_END < (4096ull << 20), "32-bit workspace offsets");
__device__ __forceinline__ void rope8(f32x4& v0, f32x4& v1, int pos, int fq, unsigned char* ws) {
    const unsigned o = (unsigned)(pos * 16 + 8 * (fq & 1)) * 4u;
    const f32x4 c0 = wsat<f32x4>(ws, (unsigned)WS_ROPEC + o), c1 = wsat<f32x4>(ws, (unsigned)WS_ROPEC + o + 16u);
    const f32x4 s0 = wsat<f32x4>(ws, (unsigned)WS_ROPES + o), s1 = wsat<f32x4>(ws, (unsigned)WS_ROPES + o + 16u);
    const float sg = (fq < 2) ? -1.f : 1.f;
#pragma unroll
    for (int e = 0; e < 4; ++e) {
        const float p0 = __shfl_xor(v0[e], 32), p1 = __shfl_xor(v1[e], 32);
        v0[e] = v0[e] * c0[e] + sg * p0 * s0[e];
        v1[e] = v1[e] * c1[e] + sg * p1 * s1[e];
    }
}
__device__ __forceinline__ int krow_of(int row) {
    if (row < NLAT) return (row >> 12) * SKV + CTX + (row & 4095);
    const int r = row - NLAT; return (r >> 8) * SKV + (r & 255);
}
__device__ __forceinline__ float ssq8(const f32x4& v0, const f32x4& v1) { return (v0[0] * v0[0] + v0[1] * v0[1]) + (v0[2] * v0[2] + v0[3] * v0[3]) + (v1[0] * v1[0] + v1[1] * v1[1]) + (v1[2] * v1[2] + v1[3] * v1[3]); }

struct EpiIn {
    static constexpr bool PERM = true;
    unsigned char* ws;
    __device__ __forceinline__ void operator()(AccRef acc, const Unit& u, int wr, int wc, int fr, int fq) const {
        const int pn = u.pn, row0 = u.pm * 256 + wr * 64 + fr, colt = wc * 32 + 8 * fq;
        f32x4 bv[2][2];
#pragma unroll
        for (int bj = 0; bj < 2; ++bj)
#pragma unroll
            for (int n = 0; n < 2; ++n) bv[bj][n] = wsat<f32x4>(ws, (unsigned)WS_BIN2 + (unsigned)(pn * 256 + bj * 128 + colt + 4 * n) * 4u);
        if (pn == 0) {
#pragma unroll
            for (int ai = 0; ai < 2; ++ai)
#pragma unroll
                for (int m = 0; m < 4; ++m) { const int row = row0 + ai * 128 + m * 16; float ss = 0.f;
#pragma unroll
                    for (int bj = 0; bj < 2; ++bj) { const f32x4 v0 = acc[ai][bj][m][0] + bv[bj][0], v1 = acc[ai][bj][m][1] + bv[bj][1];
                        ss += ssq8(v0, v1);
                        wsat<u32x4>(ws, (unsigned)WS_QLAT + (unsigned)(row * 256 + bj * 128 + colt) * 2u) = pack8(v0, v1); }
                    ss += __shfl_xor(ss, 16); ss += __shfl_xor(ss, 32);
                    if (fq == 0) wsat<float>(ws, (unsigned)WS_QSS + (unsigned)(row * 4 + wc) * 4u) = ss; }
        } else if (pn == 1) {
#pragma unroll
            for (int ai = 0; ai < 2; ++ai)
#pragma unroll
                for (int m = 0; m < 4; ++m) { const int row = row0 + ai * 128 + m * 16;
                    { const f32x4 v0 = acc[ai][0][m][0] + bv[0][0], v1 = acc[ai][0][m][1] + bv[0][1];
                      float ss = ssq8(v0, v1);
                      wsat<u32x4>(ws, (unsigned)WS_CKV + (unsigned)(row * 128 + colt) * 2u) = pack8(v0, v1);
                      ss += __shfl_xor(ss, 16); ss += __shfl_xor(ss, 32);
                      if (fq == 0) wsat<float>(ws, (unsigned)WS_KSS + (unsigned)(row * 4 + wc) * 4u) = ss; }
                    if (wc == 0) {
                        f32x4 v0 = acc[ai][1][m][0] + bv[1][0], v1 = acc[ai][1][m][1] + bv[1][1];
                        if (u.pm < 256) rope8(v0, v1, row & 4095, fq, ws);
                        const u32x4 w = pack8(v0, v1); const unsigned ko = (unsigned)WS_K + (unsigned)(krow_of(row) * QW + 64 + 8 * fq) * 2u;
#pragma unroll
                        for (int h = 0; h < NH; ++h) wsat<u32x4>(ws, ko + (unsigned)(h * DQK * 2)) = w;
                    } }
        } else {
            const int kind = (pn - 2) >> 1, cbase = ((pn - 2) & 1) * 256 + colt;
            const unsigned dbase = (unsigned)WS_SGM + (unsigned)kind * (unsigned)(WS_FIN - WS_SGM);
#pragma unroll
            for (int ai = 0; ai < 2; ++ai)
#pragma unroll
                for (int m = 0; m < 4; ++m) { const int row = row0 + ai * 128 + m * 16;
#pragma unroll
                    for (int bj = 0; bj < 2; ++bj) { f32x4 v0 = acc[ai][bj][m][0] + bv[bj][0], v1 = acc[ai][bj][m][1] + bv[bj][1];
                        if (kind != 1) { v0 = silu4(v0); v1 = silu4(v1); }
                        wsat<u32x4>(ws, dbase + (unsigned)(row * 512 + cbase + bj * 128) * 2u) = pack8(v0, v1); } }
        }
    }
};
struct EpiQ {
    static constexpr bool PERM = true;
    unsigned char* ws;
    __device__ __forceinline__ void operator()(AccRef acc, const Unit& u, int wr, int wc, int fr, int fq) const {
        const int pn = u.pn, row0 = u.pm * 256 + wr * 64 + fr, colt = wc * 32 + 8 * fq;
#pragma unroll
        for (int ai = 0; ai < 2; ++ai)
#pragma unroll
            for (int m = 0; m < 4; ++m) { const int row = row0 + ai * 128 + m * 16;
                const f32x4 q4 = wsat<f32x4>(ws, (unsigned)WS_QSS + (unsigned)row * 16u);
                const float rs = __builtin_amdgcn_rsqf(((q4[0] + q4[1]) + (q4[2] + q4[3])) * (1.f / 256.f) + LN_EPS) * C2;
#pragma unroll
                for (int bj = 0; bj < 2; ++bj) { f32x4 v0 = acc[ai][bj][m][0] * rs, v1 = acc[ai][bj][m][1] * rs;
                    if (pn < 2) { const int c = pn * 256 + bj * 128 + colt; wsat<u32x4>(ws, (unsigned)WS_Q + (unsigned)(row * QW + (c >> 6) * DQK + (c & 63)) * 2u) = pack8(v0, v1); }
                    else { rope8(v0, v1, row & 4095, fq, ws); wsat<u32x4>(ws, (unsigned)WS_Q + (unsigned)(row * QW + (4 * bj + wc) * DQK + 64 + 8 * fq) * 2u) = pack8(v0, v1); } } }
    }
};
struct EpiKV {
    static constexpr bool PERM = true;
    unsigned char* ws;
    __device__ __forceinline__ void operator()(AccRef acc, const Unit& u, int wr, int wc, int fr, int fq) const {
        const int pn = u.pn, row0 = u.pm * 256 + wr * 64 + fr, colt = wc * 32 + 8 * fq;
#pragma unroll
        for (int ai = 0; ai < 2; ++ai)
#pragma unroll
            for (int m = 0; m < 4; ++m) { const int row = row0 + ai * 128 + m * 16; const int kr = krow_of(row);
                const f32x4 q4 = wsat<f32x4>(ws, (unsigned)WS_KSS + (unsigned)row * 16u);
                const float rs = __builtin_amdgcn_rsqf(((q4[0] + q4[1]) + (q4[2] + q4[3])) * (1.f / 128.f) + LN_EPS);
#pragma unroll
                for (int bj = 0; bj < 2; ++bj) { const f32x4 v0 = acc[ai][bj][m][0] * rs, v1 = acc[ai][bj][m][1] * rs;
                    if (pn < 2) { const int c = pn * 256 + bj * 128 + colt; wsat<u32x4>(ws, (unsigned)WS_K + (unsigned)(kr * QW + (c >> 6) * DQK + (c & 63)) * 2u) = pack8(v0, v1); }
                    else { const int c = (pn - 2) * 256 + bj * 128 + colt; wsat<u32x4>(ws, (unsigned)WS_V + (unsigned)(kr * VW + c) * 2u) = pack8(v0, v1); } } }
    }
};
struct EpiF0 {
    static constexpr bool PERM = true;
    unsigned char* ws;
    __device__ __forceinline__ void operator()(AccRef acc, const Unit& u, int wr, int wc, int fr, int fq) const {
        const int bg = u.pn >> 4, bgrp = u.pn & 15;
        const unsigned base = (unsigned)WS_X + ((unsigned)((bg * 128 + wr * 64 + fr) * 64 + 4 * bgrp + (wc >> 1)) * 128u + 32u * (wc & 1) + 8u * fq) * 2u;
#pragma unroll
        for (int ai = 0; ai < 2; ++ai)
#pragma unroll
            for (int m = 0; m < 4; ++m)
#pragma unroll
                for (int bj = 0; bj < 2; ++bj)
                    wsat<u32x4>(ws, base + (unsigned)(((m * 16 * 64 + 2 * bj) * 128 + ai * 64) * 2)) = pack8(acc[ai][bj][m][0], acc[ai][bj][m][1]);
    }
};
struct EpiF1 {
    static constexpr bool PERM = true;
    unsigned char* ws;
    __device__ __forceinline__ void operator()(AccRef acc, const Unit& u, int wr, int wc, int fr, int fq) const {
        if (wr != 0) return;
        const int bg = u.pn >> 5, mq = u.pn & 31;
        const int b0 = 32 * (wc & 1) + 8 * fq;
        const unsigned base = (unsigned)WS_Y2 + ((unsigned)(((bg * 64 + fr) * 128 + 4 * mq + (wc >> 1)) * 2) * 64u + (unsigned)b0) * 2u;
        unsigned tbase = (unsigned)(fr * 64 + b0) * 4u; asm volatile("" : "+v"(tbase));
#pragma unroll
        for (int m = 0; m < 4; ++m)
#pragma unroll
            for (int n = 0; n < 2; ++n) {
                const unsigned to = tbase + (unsigned)((m * 16 * 64 + 4 * n) * 4);
                const f32x4 c = wsat<f32x4>(ws, (unsigned)WS_TWC + to), sn = wsat<f32x4>(ws, (unsigned)WS_TWS + to);
#pragma unroll
                for (int bj = 0; bj < 2; ++bj) {
                    const f32x4 re = acc[0][bj][m][n], im = acc[1][bj][m][n]; const f32x4 orr = re * c + im * sn, oi = im * c - re * sn;
                    const unsigned off = base + (unsigned)(((m * 16 * 128 + 2 * bj) * 2 * 64 + 4 * n) * 2);
                    uint2 w0, w1; w0.x = cvtpk(orr[0], orr[1]); w0.y = cvtpk(orr[2], orr[3]); w1.x = cvtpk(oi[0], oi[1]); w1.y = cvtpk(oi[2], oi[3]);
                    wsat<uint2>(ws, off) = w0; wsat<uint2>(ws, off + 128u) = w1; }
                asm volatile("" ::: "memory");
            }
    }
};
struct EpiF2 {
    static constexpr bool PERM = true;
    unsigned char* ws;
    __device__ __forceinline__ void operator()(AccRef acc, const Unit& u, int wr, int wc, int fr, int fq) const {
        if (wr != 0) return;
        const int bg = u.pn >> 5, dq = u.pn & 31, batch = bg >> 2, g = bg & 3;
#pragma unroll
        for (int m = 0; m < 4; ++m) { const int c = m * 16 + fr;
#pragma unroll
            for (int bj = 0; bj < 2; ++bj) { const int d = 2 * dq + bj, mcol0 = 32 * wc + 8 * fq;
                wsat<u32x4>(ws, (unsigned)WS_Z + (unsigned)((batch * 4096 + 64 * c + d) * 512 + 128 * g + mcol0) * 2u) = pack8(acc[0][bj][m][0], acc[0][bj][m][1]); } }
    }
};
struct EpiF3 {
    static constexpr bool PERM = true;
    unsigned char* ws; const float* bias;
    __device__ __forceinline__ void operator()(AccRef acc, const Unit& u, int wr, int wc, int fr, int fq) const {
        const int row0 = u.pm * 256 + wr * 64 + fr, col0 = u.pn * 256 + wc * 32 + 8 * fq;
        f32x4 bv[2][2];
#pragma unroll
        for (int bj = 0; bj < 2; ++bj)
#pragma unroll
            for (int n = 0; n < 2; ++n) bv[bj][n] = *(const f32x4*)(bias + col0 + bj * 128 + 4 * n);
#pragma unroll
        for (int ai = 0; ai < 2; ++ai)
#pragma unroll
            for (int m = 0; m < 4; ++m) { const int row = row0 + ai * 128 + m * 16;
#pragma unroll
                for (int bj = 0; bj < 2; ++bj) { const int c = col0 + bj * 128; const u32x4 gq = wsat<u32x4>(ws, (unsigned)WS_SGF + (unsigned)(row * 512 + c) * 2u);
                    f32x4 v0 = acc[ai][bj][m][0] + bv[bj][0], v1 = acc[ai][bj][m][1] + bv[bj][1];
                    v0 = v0 * (f32x4){bf_lo(gq.x), bf_hi(gq.x), bf_lo(gq.y), bf_hi(gq.y)}; v1 = v1 * (f32x4){bf_lo(gq.z), bf_hi(gq.z), bf_lo(gq.w), bf_hi(gq.w)};
                    wsat<u32x4>(ws, (unsigned)WS_YMIX + (unsigned)(row * 1024 + 512 + c) * 2u) = pack8(v0, v1); } }
    }
};
struct EpiOut {
    static constexpr bool PERM = false;
    unsigned char* ws; const float* bias; const float* x; float* R;
    __device__ __forceinline__ void operator()(AccRef acc, const Unit& u, int wr, int wc, int fr, int fq) const {
        const int row0 = u.pm * 256 + wr * 64 + fr, col0 = u.pn * 256 + wc * 32 + 4 * fq;
        const unsigned gate = (unsigned)WS_MOD + (unsigned)((u.pm >> 4) * 3072 + 2048 + col0) * 4u;
        f32x4 bv[2][2], gv[2][2];
#pragma unroll
        for (int bj = 0; bj < 2; ++bj)
#pragma unroll
            for (int n = 0; n < 2; ++n) { bv[bj][n] = *(const f32x4*)(bias + col0 + bj * 128 + 16 * n); gv[bj][n] = wsat<f32x4>(ws, gate + (unsigned)(bj * 128 + 16 * n) * 4u); }
#pragma unroll
        for (int ai = 0; ai < 2; ++ai)
#pragma unroll
            for (int m = 0; m < 4; ++m) { const unsigned off = (unsigned)((row0 + ai * 128 + m * 16) * 1024 + col0) * 4u;
#pragma unroll
                for (int bj = 0; bj < 2; ++bj)
#pragma unroll
                    for (int n = 0; n < 2; ++n) { const unsigned o2 = off + (unsigned)(bj * 128 + 16 * n) * 4u; const f32x4 xv = *(const f32x4*)((const unsigned char*)x + (size_t)o2);
                        *(f32x4*)((unsigned char*)R + (size_t)o2) = xv * ALPHA + gv[bj][n] * (acc[ai][bj][m][n] + bv[bj][n]); } }
    }
};

namespace att {
constexpr int KBYTES = 12288, VBYTES = 8192, BUF = KBYTES + VBYTES;
constexpr int LDS_WS = 2 * BUF, LDS_OST = LDS_WS + 8 * 256, LDS_TOTAL = LDS_OST + 8 * 4096;
constexpr int NT = SKV / 64;
__device__ __forceinline__ int crow(int r, int hi) { return (r & 3) + 8 * (r >> 2) + 4 * hi; }
__device__ __forceinline__ void attn_unit(int b, int h, int qb, const bf16_t* Q, const bf16_t* K, const bf16_t* V, const bf16_t* SGM, bf16_t* YMIX, LAS unsigned char* lds) {
    int tid_ = threadIdx.x; asm volatile("" : "+v"(tid_));
    const int tid = tid_, lane = tid & 63, r32 = lane & 31, hi = lane >> 5; const int wid = __builtin_amdgcn_readfirstlane(tid >> 6);
    const size_t krow0 = (size_t)b * SKV; const int qrow0 = b * SEQ + qb * 256 + wid * 32;
    const int kch = tid >> 6, kkey = tid & 63;
    const bf16_t* gK0 = K + (krow0 + kkey) * QW + h * DQK + kch * 8;
    const bf16_t* gK1 = gK0 + 64;
    const bf16_t* gV = V + (krow0 + ((tid >> 2) & 63)) * VW + h * DV + (tid >> 8) * 32 + (tid & 3) * 8;
    u32x4 rk0, rk1 = (u32x4){0, 0, 0, 0}, rv;
#define ATT_LOAD(t) do { rk0 = *(const u32x4*)(gK0 + (size_t)(t) * 64 * QW); if (tid < 256) rk1 = *(const u32x4*)(gK1 + (size_t)(t) * 64 * QW); rv = *(const u32x4*)(gV + (size_t)(t) * 64 * VW); } while (0)
#define ATT_WRITE(bo) do { *(LAS u32x4*)(lds + (bo) + tid * 16) = rk0; if (tid < 256) *(LAS u32x4*)(lds + (bo) + 8192 + tid * 16) = rk1; *(LAS u32x4*)(lds + (bo) + KBYTES + tid * 16) = rv; } while (0)
    ATT_LOAD(0);
    bf16x8 qr[6];
#pragma unroll
    for (int d0 = 0; d0 < 6; ++d0) qr[d0] = *(const bf16x8*)(Q + (size_t)(qrow0 + r32) * QW + h * DQK + d0 * 16 + hi * 8);
    LAS float* wsf = (LAS float*)(lds + LDS_WS) + wid * 64;
    float mrun = -1e30f, lrun = 0.f; f32x16 o[2]; o[0] = f32x16{}; o[1] = f32x16{};
    ATT_WRITE(0);
    __syncthreads();
    for (int t = 0; t < NT; ++t) {
        const int bo = (t & 1) * BUF;
        if (t + 1 < NT) ATT_LOAD(t + 1);
        f32x16 p0 = f32x16{}, p1 = f32x16{};
        { const LAS unsigned char* kp = lds + bo + hi * 1024 + r32 * 16;
#pragma unroll
          for (int d0 = 0; d0 < 6; ++d0) { const bf16x8 b0 = *(const LAS bf16x8*)(kp + d0 * 2048), b1 = *(const LAS bf16x8*)(kp + d0 * 2048 + 512);
              p0 = __builtin_amdgcn_mfma_f32_32x32x16_bf16(b0, qr[d0], p0, 0, 0, 0); p1 = __builtin_amdgcn_mfma_f32_32x32x16_bf16(b1, qr[d0], p1, 0, 0, 0); } }
        float rm = fmaxf(p0[0], p1[0]);
#pragma unroll
        for (int r = 1; r < 16; ++r) rm = fmaxf(rm, fmaxf(p0[r], p1[r]));
        rm = fmaxf(rm, __shfl_xor(rm, 32));
        if (!__all(rm <= mrun)) {
            const float mn = fmaxf(mrun, rm), al = __builtin_amdgcn_exp2f(mrun - mn); mrun = mn; lrun *= al;
            if (hi == 0) wsf[r32] = al;
            asm volatile("s_waitcnt lgkmcnt(0)" ::: "memory");
#pragma unroll
            for (int d_ = 0; d_ < 2; ++d_)
#pragma unroll
                for (int r = 0; r < 16; ++r) o[d_][r] *= wsf[crow(r, hi)];
        }
        float sacc = 0.f;
#pragma unroll
        for (int r = 0; r < 16; ++r) { p0[r] = __builtin_amdgcn_exp2f(p0[r] - mrun); p1[r] = __builtin_amdgcn_exp2f(p1[r] - mrun); sacc += p0[r] + p1[r]; }
        lrun += sacc;
        u32x4 pw[4];
#pragma unroll
        for (int i = 0; i < 4; ++i) { pw[0][i] = cvtpk(p0[2 * i], p0[2 * i + 1]); pw[1][i] = cvtpk(p0[8 + 2 * i], p0[9 + 2 * i]); pw[2][i] = cvtpk(p1[2 * i], p1[2 * i + 1]); pw[3][i] = cvtpk(p1[8 + 2 * i], p1[9 + 2 * i]); }
        { const int vb = (int)(unsigned)(uintptr_t)(lds + bo + KBYTES) + ((lane >> 4) & 1) * 32 + (lane & 3) * 8 + (4 * hi + ((lane & 15) >> 2)) * 64;
#pragma unroll
          for (int d0 = 0; d0 < 2; ++d0) { s16x4 lo[4], hh[4];
#pragma unroll
              for (int ks = 0; ks < 4; ++ks) {
                  asm volatile("ds_read_b64_tr_b16 %0,%1 offset:%c2" : "=&v"(lo[ks]) : "v"(vb), "i"(d0 * 4096 + ks * 1024) : "memory");
                  asm volatile("ds_read_b64_tr_b16 %0,%1 offset:%c2" : "=&v"(hh[ks]) : "v"(vb), "i"(d0 * 4096 + ks * 1024 + 512) : "memory"); }
              asm volatile("s_waitcnt lgkmcnt(0)" ::: "memory"); __builtin_amdgcn_sched_barrier(0);
#pragma unroll
              for (int ks = 0; ks < 4; ++ks) { const bf16x8 vf = (bf16x8){lo[ks][0], lo[ks][1], lo[ks][2], lo[ks][3], hh[ks][0], hh[ks][1], hh[ks][2], hh[ks][3]};
                  o[d0] = __builtin_amdgcn_mfma_f32_32x32x16_bf16(__builtin_bit_cast(bf16x8, pw[ks]), vf, o[d0], 0, 0, 0); } } }
        if (t + 1 < NT) ATT_WRITE(((t + 1) & 1) * BUF);
        __syncthreads();
    }
#undef ATT_LOAD
#undef ATT_WRITE
    lrun += __shfl_xor(lrun, 32);
    if (hi == 0) wsf[32 + r32] = lrun;
    asm volatile("s_waitcnt lgkmcnt(0)" ::: "memory");
    LAS bf16_t* stg = (LAS bf16_t*)(lds + LDS_OST) + wid * 2048;
#pragma unroll
    for (int r = 0; r < 16; ++r) { const int orow = crow(r, hi); const float rl = __builtin_amdgcn_rcpf(wsf[32 + orow]);
#pragma unroll
        for (int d0 = 0; d0 < 2; ++d0) stg[orow * 64 + d0 * 32 + r32] = (bf16_t)(cvtpk(o[d0][r] * rl, 0.f) & 0xffffu); }
    asm volatile("s_waitcnt lgkmcnt(0)" ::: "memory");
#pragma unroll
    for (int i = 0; i < 4; ++i) { const int row = i * 8 + (lane >> 3), ch = lane & 7; const u32x4 v = *(const LAS u32x4*)(stg + row * 64 + ch * 8);
        const size_t grow = (size_t)(qrow0 + row);
        const u32x4 g = *(const u32x4*)(SGM + grow * 512 + h * DV + ch * 8);
        u32x4 w; w.x = cvtpk(bf_lo(v.x) * bf_lo(g.x), bf_hi(v.x) * bf_hi(g.x)); w.y = cvtpk(bf_lo(v.y) * bf_lo(g.y), bf_hi(v.y) * bf_hi(g.y));
        w.z = cvtpk(bf_lo(v.z) * bf_lo(g.z), bf_hi(v.z) * bf_hi(g.z)); w.w = cvtpk(bf_lo(v.w) * bf_lo(g.w), bf_hi(v.w) * bf_hi(g.w));
        *(u32x4*)(YMIX + grow * 1024 + h * DV + ch * 8) = w; }
    __syncthreads();
}
}

__device__ __forceinline__ float cos_rev(double rev) { rev -= floor(rev); return __builtin_amdgcn_cosf((float)rev); }
__device__ __forceinline__ float sin_rev(double rev) { rev -= floor(rev); return __builtin_amdgcn_sinf((float)rev); }
__device__ __forceinline__ void transpose_item(const float* W, int K, int N, bf16_t* WT, int k0, int n0, int drow0, const float* kscale, LAS float* scr, int lane) {
#pragma unroll 8
    for (int i = 0; i < 32; ++i) { const int kk = 2 * i + (lane >> 5); float v = W[(size_t)(k0 + kk) * N + n0 + (lane & 31)]; if (kscale) v *= kscale[k0 + kk]; scr[kk * 33 + (lane & 31)] = v; }
    asm volatile("s_waitcnt lgkmcnt(0)" ::: "memory");
    const int c = lane & 7;
#pragma unroll
    for (int j = 0; j < 4; ++j) { const int n = (lane >> 3) + 8 * j; const LAS float* s = scr + (8 * c) * 33 + n;
        u32x4 o; o.x = cvtpk(s[0 * 33], s[1 * 33]); o.y = cvtpk(s[2 * 33], s[3 * 33]); o.z = cvtpk(s[4 * 33], s[5 * 33]); o.w = cvtpk(s[6 * 33], s[7 * 33]);
        *(u32x4*)(WT + (size_t)(drow0 + n) * K + k0 + 8 * c) = o; }
    asm volatile("s_waitcnt lgkmcnt(0)" ::: "memory");
}
__device__ __forceinline__ int win_drow(int j) {
    if (j < 416) return j;
    if (j < 928) return 512 + (j - 416);
    if (j < 1440) return 1024 + (j - 928);
    return 1536 + (j - 1440);
}

#ifndef PH_MASK
#define PH_MASK 0xFFFF
#endif
#define PH(k) ((PH_MASK >> (k)) & 1)
struct Args { const float* in[18]; float* out; unsigned char* ws; };

__global__ void __launch_bounds__(NTHR, 2) mk_fwd(Args a) {
    extern __shared__ __attribute__((aligned(16))) unsigned char lds_raw[];
    LAS unsigned char* lds = (LAS unsigned char*)lds_raw;
    cg::grid_group grid = cg::this_grid();
    const int tid = threadIdx.x, lane = tid & 63, wave = __builtin_amdgcn_readfirstlane(tid >> 6);
    const int G = gridDim.x, bx = blockIdx.x;
    const int vcu = (G % 8 == 0) ? (bx % 8) * (G / 8) + bx / 8 : bx;
    const int gw = bx * 8 + wave, NGW = G * 8;
#define KARGS() ([]() __attribute__((always_inline)) { const __attribute__((address_space(4))) Args* p_ = (const __attribute__((address_space(4))) Args*)__builtin_amdgcn_kernarg_segment_ptr(); asm volatile("" : "+s"(p_)); return p_; }())
#define WS() ((unsigned char*)KARGS()->ws)
#define INP(i) ((const float*)KARGS()->in[i])
    if (PH(0)) {
    unsigned char* ws = WS();
    if (bx < 192) {
        const float *cvec = INP(1), *c_ctx = INP(3), *w_ada = INP(4), *b_ada = INP(5);
        float* MOD = (float*)(ws + WS_MOD);
        LAS float* S = (LAS float*)lds;
        LAS float* red = S + 17 * 1024;
        for (int i = tid; i < 17 * 1024; i += NTHR) { const float v = i < 16 * 1024 ? cvec[i] : c_ctx[i - 16 * 1024]; S[i] = v / (1.f + __expf(-v)); }
        __syncthreads();
        const int col = tid & 15, ks = tid >> 4, col0 = bx * 16;
        float acc[17];
#pragma unroll
        for (int r = 0; r < 17; ++r) acc[r] = 0.f;
        for (int k = ks; k < 1024; k += 32) { const float w = w_ada[(size_t)k * 3072 + col0 + col];
#pragma unroll
            for (int r = 0; r < 17; ++r) acc[r] += S[r * 1024 + k] * w; }
#pragma unroll
        for (int r = 0; r < 17; ++r) red[(ks * 17 + r) * 16 + col] = acc[r];
        __syncthreads();
        if (tid < 272) { const int r = tid >> 4, cc = tid & 15; float s = 0.f;
            for (int k2 = 0; k2 < 32; ++k2) s += red[(k2 * 17 + r) * 16 + cc];
            MOD[r * 3072 + col0 + cc] = s + b_ada[col0 + cc]; }
        __syncthreads();
    }
    {
        LAS float* scr = (LAS float*)(lds + wave * 16384);
        constexpr int I_IN = 16 * 61, I_Q = 4 * 24, I_KV = 2 * 32, I_F = 8 * 16, I_O = 16 * 32, NITEMS = I_IN + I_Q + I_KV + I_F + I_O;
        for (int it = gw; it < NITEMS; it += NGW) {
            int r = it;
            if (r < I_IN) { const int kb = r / 61, nb = r % 61; transpose_item(INP(6), 1024, 1952, (bf16_t*)(ws + WS_WIN), 64 * kb, 32 * nb, win_drow(32 * nb), nullptr, scr, lane); continue; } r -= I_IN;
            if (r < I_Q) { const int kb = r / 24, nb = r % 24, hh = nb / 3, part = nb % 3; const int dr = part < 2 ? hh * 64 + part * 32 : 512 + hh * 32;
                transpose_item(INP(9), 256, 768, (bf16_t*)(ws + WS_WQ), 64 * kb, 32 * nb, dr, INP(8), scr, lane); continue; } r -= I_Q;
            if (r < I_KV) { const int kb = r / 32, nb = r % 32, hh = nb / 4, part = nb % 4; const int dr = part < 2 ? hh * 64 + part * 32 : 512 + hh * 64 + (part - 2) * 32;
                transpose_item(INP(11), 128, 1024, (bf16_t*)(ws + WS_WKV), 64 * kb, 32 * nb, dr, INP(10), scr, lane); continue; } r -= I_KV;
            if (r < I_F) { const int kb = r / 16, nb = r % 16; transpose_item(INP(12), 512, 512, (bf16_t*)(ws + WS_WF), 64 * kb, 32 * nb, 32 * nb, nullptr, scr, lane); continue; } r -= I_F;
            { const int kb = r / 32, nb = r % 32; transpose_item(INP(14), 1024, 1024, (bf16_t*)(ws + WS_WO), 64 * kb, 32 * nb, 32 * nb, nullptr, scr, lane); }
        }
    }
    {
        float* ropeC = (float*)(ws + WS_ROPEC); float* ropeS = (float*)(ws + WS_ROPES);
        float* TWC = (float*)(ws + WS_TWC); float* TWS = (float*)(ws + WS_TWS); float* BIN2 = (float*)(ws + WS_BIN2);
        bf16_t *FcT = (bf16_t*)(ws + WS_FC), *G1 = (bf16_t*)(ws + WS_G1), *G2 = (bf16_t*)(ws + WS_G2), *WinT = (bf16_t*)(ws + WS_WIN);
        const float* b_in = INP(7);
        const int gt = bx * NTHR + tid, NT_ = G * NTHR;
        const double INV2PI = 0.15915494309189535;
        for (int i = gt; i < 4096 * 16; i += NT_) { const int pos = i >> 4, aa = i & 15; const int comp = aa < 8 ? (pos >> 6) : (pos & 63); const int fi = aa & 7;
            const double invf = fi == 0 ? 1.0 : fi == 1 ? 0.31622776601683794 : fi == 2 ? 0.1 : fi == 3 ? 0.031622776601683794 : fi == 4 ? 0.01 : fi == 5 ? 0.0031622776601683794 : fi == 6 ? 0.001 : 0.00031622776601683794;
            const double rev = (double)comp * invf * INV2PI; ropeC[i] = cos_rev(rev); ropeS[i] = sin_rev(rev); }
        for (int i = gt; i < 4096; i += NT_) { const int d = i >> 6, b = i & 63; const double rev = (double)((b * d) & 4095) / 4096.0; TWC[i] = cos_rev(rev); TWS[i] = sin_rev(rev); }
        for (int i = gt; i < 256 * 128; i += NT_) { const int r = i >> 7, kk = i & 127;
            { const int part = r >> 7, mc = r & 127; const double rev = (double)((kk * mc) & 127) / 128.0; const float v = part == 0 ? cos_rev(rev) : -sin_rev(rev); FcT[i] = (bf16_t)(cvtpk(v, 0.f) & 0xffffu); }
            { const int ai = r >> 7, q = r & 127, part = kk >> 6, aa = kk & 63; float v = 0.f;
              if (q < 64) { const double rev = (double)((aa * q) & 63) / 64.0; v = ai == 0 ? (part == 0 ? cos_rev(rev) : sin_rev(rev)) : (part == 0 ? -sin_rev(rev) : cos_rev(rev)); }
              G1[i] = (bf16_t)(cvtpk(v, 0.f) & 0xffffu); }
            { const int part = kk >> 6, bb = kk & 63; float v = 0.f;
              if (r < 64) { const double rev = (double)((bb * r) & 63) / 64.0; v = (part == 0 ? cos_rev(rev) : sin_rev(rev)) * FNORM; }
              G2[i] = (bf16_t)(cvtpk(v, 0.f) & 0xffffu); } }
        for (int i = gt; i < 2048; i += NT_) { float v = 0.f;
            if (i < 416) v = b_in[i]; else if (i >= 512 && i < 1024) v = b_in[416 + (i - 512)]; else if (i >= 1024 && i < 1536) v = b_in[928 + (i - 1024)]; else if (i >= 1536) v = b_in[1440 + (i - 1536)];
            BIN2[i] = v; }
        for (int i = gt; i < 96 * 1024 / 8; i += NT_) *(u32x4*)(WinT + (size_t)416 * 1024 + (size_t)i * 8) = (u32x4){0, 0, 0, 0};
    }
    }
    grid.sync();

    if (PH(1)) {
    unsigned char* ws = WS(); const float *x = INP(0), *ctx = INP(2);
    const float* MOD = (const float*)(ws + WS_MOD); bf16_t* XN = (bf16_t*)(ws + WS_XN);
    for (int m = gw; m < NROW; m += NGW) {
        const float* src = m < NLAT ? x + (size_t)m * DM : ctx + (size_t)(m - NLAT) * DM;
        const float* mod = MOD + (size_t)(m < NLAT ? (m >> 12) : 16) * 3072;
        const f32x4* xr = (const f32x4*)src + lane;
        f32x4 v[4]; float s = 0.f;
#pragma unroll
        for (int j = 0; j < 4; ++j) { v[j] = xr[64 * j]; s += (v[j][0] + v[j][1]) + (v[j][2] + v[j][3]); }
        const float mean = wave_sum(s) * (1.f / DM); float s2 = 0.f;
#pragma unroll
        for (int j = 0; j < 4; ++j) { v[j] = v[j] - mean; s2 += (v[j][0] * v[j][0] + v[j][1] * v[j][1]) + (v[j][2] * v[j][2] + v[j][3] * v[j][3]); }
        const float rstd = 1.f / sqrtf(wave_sum(s2) * (1.f / DM) + LN_EPS);
        uint2* o8 = (uint2*)(XN + (size_t)m * DM) + lane;
#pragma unroll
        for (int j = 0; j < 4; ++j) { const f32x4 sh = ((const f32x4*)mod)[lane + 64 * j], sc = ((const f32x4*)(mod + 1024))[lane + 64 * j];
            const f32x4 hv = v[j] * rstd * (sc + 1.f) + sh; uint2 w; w.x = cvtpk(hv[0], hv[1]); w.y = cvtpk(hv[2], hv[3]); o8[64 * j] = w; }
    }
    }
    grid.sync();

    if (PH(2)) {
        unsigned char* ws = WS();
        pg8::ProbRM P{(const bf16_t*)(ws + WS_XN), (const bf16_t*)(ws + WS_WIN), 1024, 1024, 16};
        pg8::GridOrder S; S.init(256, 8, G, bx, 16, 1);
        EpiIn E{ws};
        pg8::gemm_phase(lds, P, S, E);
    }
    grid.sync();

    if (PH(3)) {
        unsigned char* ws = WS();
        pg8::ProbRM P{(const bf16_t*)(ws + WS_QLAT), (const bf16_t*)(ws + WS_WQ), 256, 256, 4}; pg8::GridOrder S; S.init(256, 3, G, bx);
        EpiQ E{ws};
        pg8::gemm_phase(lds, P, S, E);
    }
    if (PH(4)) {
        unsigned char* ws = WS();
        pg8::ProbRM P{(const bf16_t*)(ws + WS_CKV), (const bf16_t*)(ws + WS_WKV), 128, 128, 2}; pg8::GridOrder S; S.init(272, 4, G, bx);
        EpiKV E{ws};
        pg8::gemm_phase(lds, P, S, E);
    }
    if (PH(5)) {
        unsigned char* ws = WS();
        pg8::ProbF0 P{(const bf16_t*)(ws + WS_FC), (const bf16_t*)(ws + WS_FIN), 2}; pg8::LinOrder S; S.init(1024, G, bx);
        EpiF0 E{ws};
        pg8::gemm_phase(lds, P, S, E);
    }
    grid.sync();

    if (PH(6)) {
        unsigned char* ws = WS();
        pg8::ProbRM P{(const bf16_t*)(ws + WS_G1), (const bf16_t*)(ws + WS_X), 128, 128, 2}; pg8::LinOrder S; S.init(2048, G, bx);
        EpiF1 E{ws};
        pg8::gemm_phase(lds, P, S, E);
    }
    grid.sync();

    if (PH(7)) {
        unsigned char* ws = WS();
        pg8::ProbRM P{(const bf16_t*)(ws + WS_G2), (const bf16_t*)(ws + WS_Y2), 128, 128, 2}; pg8::LinOrder S; S.init(2048, G, bx);
        EpiF2 E{ws};
        pg8::gemm_phase(lds, P, S, E);
    }
    grid.sync();

#ifndef NO_ATT
    if (PH(8)) {
    unsigned char* ws = WS();
    for (int i = 0;; ++i) { const int L = i * G + vcu; if (L >= 2048) break; const int bh = L >> 4, qb = L & 15;
        att::attn_unit(bh >> 3, bh & 7, qb, (const bf16_t*)(ws + WS_Q), (const bf16_t*)(ws + WS_K), (const bf16_t*)(ws + WS_V), (const bf16_t*)(ws + WS_SGM), (bf16_t*)(ws + WS_YMIX), lds); }
    }
#else
    { bf16_t* YMIX = (bf16_t*)(WS() + WS_YMIX);
    for (int m = gw; m < NLAT; m += NGW) *(u32x4*)(YMIX + (size_t)m * 1024 + lane * 8) = (u32x4){0, 0, 0, 0}; }
#endif
    if (PH(9)) {
        unsigned char* ws = WS();
        pg8::ProbRM P{(const bf16_t*)(ws + WS_Z), (const bf16_t*)(ws + WS_WF), 512, 512, 8}; pg8::GridOrder S; S.init(256, 2, G, bx);
        EpiF3 E{ws, INP(13)};
        pg8::gemm_phase(lds, P, S, E);
    }
    grid.sync();

    if (PH(10)) {
        unsigned char* ws = WS();
        pg8::ProbRM P{(const bf16_t*)(ws + WS_YMIX), (const bf16_t*)(ws + WS_WO), 1024, 1024, 16}; pg8::GridOrder S; S.init(256, 4, G, bx);
        EpiOut E{ws, INP(15), INP(0), (float*)KARGS()->out};
        pg8::gemm_phase(lds, P, S, E);
    }
    grid.sync();

    if (PH(11)) {
    float* outp = (float*)KARGS()->out; const float *post_g = INP(16), *post_b = INP(17);
    for (int m = gw; m < NLAT; m += NGW) {
        f32x4* xr = (f32x4*)(outp + (size_t)m * DM) + lane;
        f32x4 v[4]; float s = 0.f;
#pragma unroll
        for (int j = 0; j < 4; ++j) { v[j] = xr[64 * j]; s += (v[j][0] + v[j][1]) + (v[j][2] + v[j][3]); }
        const float mean = wave_sum(s) * (1.f / DM); float s2 = 0.f;
#pragma unroll
        for (int j = 0; j < 4; ++j) { v[j] = v[j] - mean; s2 += (v[j][0] * v[j][0] + v[j][1] * v[j][1]) + (v[j][2] * v[j][2] + v[j][3] * v[j][3]); }
        const float rstd = 1.f / sqrtf(wave_sum(s2) * (1.f / DM) + LN_EPS);
#pragma unroll
        for (int j = 0; j < 4; ++j) { const f32x4 gg = ((const f32x4*)post_g)[lane + 64 * j], b4 = ((const f32x4*)post_b)[lane + 64 * j]; xr[64 * j] = v[j] * rstd * gg + b4; }
    }
    }
}

extern "C" void kernel_launch(void* const* d_in, const int* in_sizes, int n_in, void* d_out, int out_size, void* d_ws, size_t ws_size, hipStream_t stream) {
    static int grid = 0;
    if (grid == 0) {
        if (n_in != 18 || out_size != NLAT * DM || ws_size < WS_END) { fprintf(stderr, "kernel_launch: unexpected shapes: n_in %d out %d ws %zu (need %zu)\n", n_in, out_size, ws_size, (size_t)WS_END); grid = -1; return; }
        int dev = 0, cus = 0, per_cu = 0;
        (void)hipGetDevice(&dev);
        (void)hipDeviceGetAttribute(&cus, hipDeviceAttributeMultiprocessorCount, dev);
        (void)hipFuncSetAttribute((const void*)mk_fwd, hipFuncAttributeMaxDynamicSharedMemorySize, LDS_BYTES);
        (void)hipOccupancyMaxActiveBlocksPerMultiprocessor(&per_cu, (const void*)mk_fwd, NTHR, LDS_BYTES);
        if (per_cu < 1) { fprintf(stderr, "kernel_launch: occupancy query reports %d blocks/CU\n", per_cu); grid = -1; return; }
        grid = cus;
    }
    if (grid < 0) return;
    Args a{};
    for (int i = 0; i < 18; ++i) a.in[i] = (const float*)d_in[i];
    a.out = (float*)d_out; a.ws = (unsigned char*)d_ws;
    void* args[] = {&a};
    hipError_t e = hipLaunchCooperativeKernel((const void*)mk_fwd, dim3(grid), dim3(NTHR), args, LDS_BYTES, stream);
    if (e != hipSuccess) fprintf(stderr, "cooperative launch failed: %s (grid %d)\n", hipGetErrorString(e), grid);
}
```

```cpp
#include <hip/hip_runtime.h>
#include <hip/hip_cooperative_groups.h>
#include <cstdio>
#include <cstdint>
namespace cg = cooperative_groups;

#define LAS __attribute__((address_space(3)))
typedef unsigned short bf16_t;
typedef short bf16x8 __attribute__((ext_vector_type(8)));
typedef short s16x4 __attribute__((ext_vector_type(4)));
typedef float f32x4 __attribute__((ext_vector_type(4)));
typedef float f32x16 __attribute__((ext_vector_type(16)));
typedef unsigned u32x4 __attribute__((ext_vector_type(4)));
typedef float f32x2_t __attribute__((ext_vector_type(2)));
typedef __bf16 bf16x2_t __attribute__((ext_vector_type(2)));

constexpr int NTHR = 512;
constexpr int LDS_BYTES = 147456;
constexpr int DM = 1024, BATCH = 16, SEQ = 4096, CTX = 256, NLAT = BATCH * SEQ  , NCTX = BATCH * CTX  , NROW = NLAT + NCTX  ;
constexpr int SKV = CTX + SEQ;
constexpr int NH = 8, DQK = 96, DV = 64, QW = NH * DQK  , VW = NH * DV  ;
constexpr float LN_EPS = 1e-6f;
constexpr float ALPHA = 1.189207115002721f;
constexpr float C2 = 1.4426950408889634f * 0.10206207261596577f;
constexpr float FNORM = 0.0013810679320049757f;

constexpr size_t MiB = 1u << 20;
constexpr size_t WS_MOD = 1 * MiB;
constexpr size_t WS_ROPEC = 2 * MiB, WS_ROPES = 2 * MiB + 262144;
constexpr size_t WS_TWC = 2 * MiB + 524288, WS_TWS = WS_TWC + 16384;
constexpr size_t WS_BIN2 = WS_TWS + 16384;
constexpr size_t WS_WIN = 4 * MiB;
constexpr size_t WS_WO = 8 * MiB;
constexpr size_t WS_WQ = 10 * MiB;
constexpr size_t WS_WKV = 10 * MiB + 524288;
constexpr size_t WS_WF = 11 * MiB;
constexpr size_t WS_FC = 11 * MiB + 524288;
constexpr size_t WS_G1 = WS_FC + 65536, WS_G2 = WS_G1 + 65536;
constexpr size_t WS_QSS = 12 * MiB;
constexpr size_t WS_KSS = 13 * MiB;
constexpr size_t WS_XN = 16 * MiB;
constexpr size_t WS_X = WS_XN;
constexpr size_t WS_QLAT = 152 * MiB;
constexpr size_t WS_CKV = 184 * MiB;
constexpr size_t WS_SGM = 202 * MiB;
constexpr size_t WS_FIN = 266 * MiB;
constexpr size_t WS_SGF = 330 * MiB;
constexpr size_t WS_Q = 394 * MiB;
constexpr size_t WS_K = 490 * MiB;
constexpr size_t WS_V = 592 * MiB;
constexpr size_t WS_Y2 = 660 * MiB;
constexpr size_t WS_Z = 788 * MiB;
constexpr size_t WS_YMIX = 852 * MiB;
constexpr size_t WS_END = 980 * MiB;
static_assert(WS_SGF - WS_FIN == WS_FIN - WS_SGM, "SGM|FIN|SGF equally spaced");

__device__ __forceinline__ float wave_sum(float v) {
#pragma unroll
    for (int o = 1; o < 64; o <<= 1) v += __shfl_xor(v, o);
    return v;
}
__device__ __forceinline__ unsigned cvtpk(float lo, float hi) { f32x2_t v = {lo, hi}; bf16x2_t b = __builtin_convertvector(v, bf16x2_t); return __builtin_bit_cast(unsigned, b); }
__device__ __forceinline__ u32x4 pack8(const f32x4& a, const f32x4& b) { u32x4 w; w.x = cvtpk(a[0], a[1]); w.y = cvtpk(a[2], a[3]); w.z = cvtpk(b[0], b[1]); w.w = cvtpk(b[2], b[3]); return w; }
__device__ __forceinline__ float bf_lo(unsigned u) { return __uint_as_float(u << 16); }
__device__ __forceinline__ float bf_hi(unsigned u) { return __uint_as_float(u & 0xffff0000u); }
__device__ __forceinline__ float silu_f(float v) { return v * __builtin_amdgcn_rcpf(1.f + __expf(-v)); }
__device__ __forceinline__ f32x4 silu4(const f32x4& v) { return (f32x4){silu_f(v[0]), silu_f(v[1]), silu_f(v[2]), silu_f(v[3])}; }

namespace pg8 {
constexpr int BM = 256, BK = 64, HALF = 128, HTB = HALF * BK * 2, STAGE_BYTES = 8 * HTB, NXCD = 8, WGM = 8;
__device__ __forceinline__ int lds_byte(int r, int c) { const int st = (r >> 4) * 2 + (c >> 5), rr = r & 15, cc = c & 31, ob = rr * 64 + cc * 2; return st * 1024 + (ob ^ (((ob >> 9) & 1) << 5)); }
__device__ __forceinline__ void stage_rc(int b, int& R, int& C) { const int st = b / 1024, sb = b % 1024, swz = sb ^ (((sb >> 9) & 1) << 5); R = (st >> 1) * 16 + swz / 64; C = (st & 1) * 32 + (swz % 64) / 2; }
__device__ __forceinline__ int perm32(int rho) { const int n = rho >> 4, i = rho & 15; return 8 * (i >> 2) + 4 * n + (i & 3); }
struct Unit { int pm, pn; };

struct GridOrder {
    int nM, nN, nwg, G, c, extra, extra_pn;
    __device__ void init(int nM_, int nN_, int G_, int c_, int extra_ = 0, int extra_pn_ = 0) { nM = nM_; nN = nN_; nwg = nM * nN; G = G_; c = c_; extra = extra_; extra_pn = extra_pn_; }
    __device__ bool next(int i, Unit& u) const {
        const long L = (long)i * G + c;
        if (L >= nwg) { if (L < nwg + extra) { u.pm = nM + (int)(L - nwg); u.pn = extra_pn; return true; } return false; }
        int wgid = (int)L; { const int q = nwg / NXCD, r = nwg % NXCD, xcd = wgid % NXCD, off = wgid / NXCD; wgid = (xcd < r ? xcd * (q + 1) : r * (q + 1) + (xcd - r) * q) + off; }
        const int nig = WGM * nN, gid = wgid / nig, fm = gid * WGM, gsz = (nM - fm) < WGM ? (nM - fm) : WGM;
        u.pm = fm + ((wgid % nig) % gsz); u.pn = (wgid % nig) / gsz; return true;
    }
};
struct LinOrder {
    int n, G, c;
    __device__ void init(int n_, int G_, int c_) { n = n_; G = G_; c = c_; }
    __device__ bool next(int i, Unit& u) const { const long L = (long)i * G + c; if (L >= n) return false; u.pm = 0; u.pn = (int)L; return true; }
};

struct ProbRM {
    const bf16_t* A; const bf16_t* Bt; int lda, ldb, nt;
    __device__ __forceinline__ unsigned offA(int R, int C) const { return (unsigned)(R * lda + C) * 2u; }
    __device__ __forceinline__ unsigned offB(int R, int C) const { return (unsigned)(R * ldb + C) * 2u; }
    __device__ __forceinline__ size_t hstepA() const { return (size_t)HALF * lda * 2; }
    __device__ __forceinline__ size_t hstepB() const { return (size_t)HALF * ldb * 2; }
    __device__ __forceinline__ const char* baseA(const Unit& u) const { return (const char*)A + (size_t)u.pm * BM * lda * 2; }
    __device__ __forceinline__ const char* baseB(const Unit& u) const { return (const char*)Bt + (size_t)u.pn * BM * ldb * 2; }
};
struct ProbF0 {
    const bf16_t* A; const bf16_t* FIN; int nt;
    __device__ __forceinline__ unsigned offA(int R, int C) const { return (unsigned)(R * 128 + C) * 2u; }
    __device__ __forceinline__ unsigned offB(int R, int C) const { return (unsigned)((64 * (R & 63) + (R >> 6)) * 512 + C) * 2u; }
    __device__ __forceinline__ size_t hstepA() const { return (size_t)HALF * 128 * 2; }
    __device__ __forceinline__ size_t hstepB() const { return (size_t)2 * 512 * 2; }
    __device__ __forceinline__ const char* baseA(const Unit&) const { return (const char*)A; }
    __device__ __forceinline__ const char* baseB(const Unit& u) const { const int bg = u.pn >> 4, bgrp = u.pn & 15, batch = bg >> 2, g = bg & 3; return (const char*)FIN + ((size_t)(batch * 4096 + 4 * bgrp) * 512 + 128 * g) * 2; }
};

template <class Prob, class Epi, class Sched>
__device__ __forceinline__ void gemm_phase(LAS unsigned char* lds, const Prob& P, const Sched& S, const Epi& E) {
    int tid_ = threadIdx.x; asm volatile("" : "+v"(tid_));
    const int tid = tid_, wid = __builtin_amdgcn_readfirstlane(tid >> 6), lane = tid & 63, wr = wid >> 2, wc = wid & 3, fr = lane & 15, fq = lane >> 4;
    const int nt = P.nt;
    unsigned voffA[2], voffB[2];
#pragma unroll
    for (int i = 0; i < 2; ++i) { int R, C; stage_rc(tid * 16 + i * 8192, R, C); const int Rb = Epi::PERM ? ((R & ~31) + perm32(R & 31)) : R;
        voffA[i] = P.offA(R, C); voffB[i] = P.offB(Rb, C); }
    const size_t kstep = (size_t)(BK * 2);
    const size_t hstepA = P.hstepA(), hstepB = P.hstepB();
    const unsigned ldsw = (unsigned)wid * 1024u;
    const int aoff = lds_byte(wr * 64 + fr, fq * 8), boff = lds_byte(wc * 32 + fr, fq * 8);
#define PG8_SA(b, h) (((b) * 2 + (h)) * HTB)
#define PG8_SB(b, h) ((4 + (b) * 2 + (h)) * HTB)
#define PG8_STAGE(bufoff, gbase, voff) do { _Pragma("unroll") for (int _i = 0; _i < 2; ++_i) \
        __builtin_amdgcn_global_load_lds((const unsigned*)((const char*)(gbase) + (voff)[_i]), (LAS unsigned*)(lds + (bufoff) + ldsw + _i * 8192), 16, 0, 0); } while (0)
#define PG8_LDA(dst, b, h) do { _Pragma("unroll") for (int m = 0; m < 4; ++m) _Pragma("unroll") for (int k = 0; k < 2; ++k) dst[m][k] = *(const LAS bf16x8*)(lds + PG8_SA(b, h) + aoff + m * 2048 + k * 1024); } while (0)
#define PG8_LDB(dst, b, h) do { _Pragma("unroll") for (int n = 0; n < 2; ++n) _Pragma("unroll") for (int k = 0; k < 2; ++k) dst[n][k] = *(const LAS bf16x8*)(lds + PG8_SB(b, h) + boff + n * 2048 + k * 1024); } while (0)
#define PG8_MMA(ai, bj, At, Bt) do { __builtin_amdgcn_s_setprio(1); _Pragma("unroll") for (int m = 0; m < 4; ++m) _Pragma("unroll") for (int n = 0; n < 2; ++n) _Pragma("unroll") for (int k = 0; k < 2; ++k) \
        acc[ai][bj][m][n] = __builtin_amdgcn_mfma_f32_16x16x32_bf16(Bt[n][k], At[m][k], acc[ai][bj][m][n], 0, 0, 0); __builtin_amdgcn_s_setprio(0); } while (0)
#define PG8_WAIT_V(n) asm volatile("s_waitcnt vmcnt(" #n ")" ::: "memory")
#define PG8_WAIT_L(n) asm volatile("s_waitcnt lgkmcnt(" #n ")" ::: "memory")
#define PG8_BAR __builtin_amdgcn_s_barrier()
#define PG8_SCHED __builtin_amdgcn_sched_barrier(0)
    Unit cur, nxt; int ui = 0;
    if (!S.next(0, cur)) return;
    f32x4 acc[2][2][4][2];
#pragma unroll
    for (int a = 0; a < 2; ++a)
#pragma unroll
        for (int b = 0; b < 2; ++b)
#pragma unroll
            for (int m = 0; m < 4; ++m)
#pragma unroll
                for (int n = 0; n < 2; ++n) acc[a][b][m][n] = (f32x4){0.f, 0.f, 0.f, 0.f};
    bf16x8 At[4][2], B0[2][2], B1[2][2];
    const char* cA = P.baseA(cur); const char* cB = P.baseB(cur);
    PG8_STAGE(PG8_SB(0, 0), cB, voffB); PG8_STAGE(PG8_SB(0, 1), cB + hstepB, voffB); PG8_STAGE(PG8_SA(0, 0), cA, voffA); PG8_STAGE(PG8_SA(0, 1), cA + hstepA, voffA);
    if (wr == 1) PG8_BAR;
    PG8_WAIT_V(2); PG8_BAR;
    PG8_STAGE(PG8_SB(1, 0), cB + kstep, voffB); PG8_STAGE(PG8_SA(1, 0), cA + kstep, voffA); PG8_STAGE(PG8_SB(1, 1), cB + hstepB + kstep, voffB);
    PG8_WAIT_V(6); PG8_BAR;
    for (;;) {
        const bool has_next = S.next(ui + 1, nxt);
        const char* nA = has_next ? P.baseA(nxt) : cA; const char* nB = has_next ? P.baseB(nxt) : cB;
        for (int t = 0; t < nt; t += 2) {
            const bool last = (t == nt - 2);
            const char* a1 = cA + (size_t)(t + 1) * kstep;
            const char* a2 = last ? nA : cA + (size_t)(t + 2) * kstep; const char* b2 = last ? nB : cB + (size_t)(t + 2) * kstep;
            const char* a3 = a2 + kstep; const char* b3 = b2 + kstep;
            asm volatile("" : "+s"(a1), "+s"(a2), "+s"(b2), "+s"(a3), "+s"(b3));
            PG8_LDB(B0, 0, 0); PG8_LDB(B1, 0, 1); PG8_SCHED; PG8_LDA(At, 0, 0); PG8_STAGE(PG8_SA(1, 1), a1 + hstepA, voffA);
            PG8_WAIT_V(8); PG8_WAIT_L(0); PG8_BAR; PG8_MMA(0, 0, At, B0); PG8_MMA(0, 1, At, B1); PG8_BAR; PG8_SCHED;
            PG8_LDA(At, 0, 1); PG8_STAGE(PG8_SB(0, 0), b2, voffB); PG8_STAGE(PG8_SB(0, 1), b2 + hstepB, voffB); PG8_STAGE(PG8_SA(0, 0), a2, voffA);
            PG8_WAIT_V(8); PG8_WAIT_L(0); PG8_BAR; PG8_MMA(1, 0, At, B0); PG8_MMA(1, 1, At, B1); PG8_BAR; PG8_SCHED;
            PG8_LDB(B0, 1, 0); PG8_LDB(B1, 1, 1); PG8_SCHED; PG8_LDA(At, 1, 0); PG8_STAGE(PG8_SA(0, 1), a2 + hstepA, voffA);
            PG8_WAIT_V(8); PG8_WAIT_L(0); PG8_BAR; PG8_MMA(0, 0, At, B0); PG8_MMA(0, 1, At, B1); PG8_BAR; PG8_SCHED;
            PG8_LDA(At, 1, 1); PG8_STAGE(PG8_SB(1, 0), b3, voffB); PG8_STAGE(PG8_SB(1, 1), b3 + hstepB, voffB); PG8_STAGE(PG8_SA(1, 0), a3, voffA);
            PG8_WAIT_V(8); PG8_WAIT_L(0); PG8_BAR; PG8_MMA(1, 0, At, B0); PG8_MMA(1, 1, At, B1); PG8_BAR; PG8_SCHED;
        }
        if (wr == 0) PG8_BAR;
        E(acc, cur, wr, wc, fr, fq);
        if (!has_next) break;
#pragma unroll
        for (int a = 0; a < 2; ++a)
#pragma unroll
            for (int b = 0; b < 2; ++b)
#pragma unroll
                for (int m = 0; m < 4; ++m)
#pragma unroll
                    for (int n = 0; n < 2; ++n) acc[a][b][m][n] = (f32x4){0.f, 0.f, 0.f, 0.f};
        cur = nxt; cA = nA; cB = nB; ++ui;
        if (wr == 1) PG8_BAR;
    }
    PG8_WAIT_V(0);
    PG8_BAR;
#undef PG8_SA
#undef PG8_SB
#undef PG8_STAGE
#undef PG8_LDA
#undef PG8_LDB
#undef PG8_MMA
#undef PG8_WAIT_V
#undef PG8_WAIT_L
#undef PG8_BAR
#undef PG8_SCHED
}
}
using pg8::Unit;
typedef const f32x4 (&AccRef)[2][2][4][2];

template <class T> __device__ __forceinline__ T& wsat(unsigned char* ws, unsigned off) { return *(T*)(ws + (size_t)off); }
static_assert(WS_END < (4096ull << 20), "32-bit workspace offsets");
__device__ __forceinline__ void rope8(f32x4& v0, f32x4& v1, int pos, int fq, unsigned char* ws) {
    const unsigned o = (unsigned)(pos * 16 + 8 * (fq & 1)) * 4u;
    const f32x4 c0 = wsat<f32x4>(ws, (unsigned)WS_ROPEC + o), c1 = wsat<f32x4>(ws, (unsigned)WS_ROPEC + o + 16u);
    const f32x4 s0 = wsat<f32x4>(ws, (unsigned)WS_ROPES + o), s1 = wsat<f32x4>(ws, (unsigned)WS_ROPES + o + 16u);
    const float sg = (fq < 2) ? -1.f : 1.f;
#pragma unroll
    for (int e = 0; e < 4; ++e) {
        const float p0 = __shfl_xor(v0[e], 32), p1 = __shfl_xor(v1[e], 32);
        v0[e] = v0[e] * c0[e] + sg * p0 * s0[e];
        v1[e] = v1[e] * c1[e] + sg * p1 * s1[e];
    }
}
__device__ __forceinline__ int krow_of(int row) {
    if (row < NLAT) return (row >> 12) * SKV + CTX + (row & 4095);
    const int r = row - NLAT; return (r >> 8) * SKV + (r & 255);
}
__device__ __forceinline__ float ssq8(const f32x4& v0, const f32x4& v1) { return (v0[0] * v0[0] + v0[1] * v0[1]) + (v0[2] * v0[2] + v0[3] * v0[3]) + (v1[0] * v1[0] + v1[1] * v1[1]) + (v1[2] * v1[2] + v1[3] * v1[3]); }

struct EpiIn {
    static constexpr bool PERM = true;
    unsigned char* ws;
    __device__ __forceinline__ void operator()(AccRef acc, const Unit& u, int wr, int wc, int fr, int fq) const {
        const int pn = u.pn, row0 = u.pm * 256 + wr * 64 + fr, colt = wc * 32 + 8 * fq;
        f32x4 bv[2][2];
#pragma unroll
        for (int bj = 0; bj < 2; ++bj)
#pragma unroll
            for (int n = 0; n < 2; ++n) bv[bj][n] = wsat<f32x4>(ws, (unsigned)WS_BIN2 + (unsigned)(pn * 256 + bj * 128 + colt + 4 * n) * 4u);
        if (pn == 0) {
#pragma unroll
            for (int ai = 0; ai < 2; ++ai)
#pragma unroll
                for (int m = 0; m < 4; ++m) { const int row = row0 + ai * 128 + m * 16; float ss = 0.f;
#pragma unroll
                    for (int bj = 0; bj < 2; ++bj) { const f32x4 v0 = acc[ai][bj][m][0] + bv[bj][0], v1 = acc[ai][bj][m][1] + bv[bj][1];
                        ss += ssq8(v0, v1);
                        wsat<u32x4>(ws, (unsigned)WS_QLAT + (unsigned)(row * 256 + bj * 128 + colt) * 2u) = pack8(v0, v1); }
                    ss += __shfl_xor(ss, 16); ss += __shfl_xor(ss, 32);
                    if (fq == 0) wsat<float>(ws, (unsigned)WS_QSS + (unsigned)(row * 4 + wc) * 4u) = ss; }
        } else if (pn == 1) {
#pragma unroll
            for (int ai = 0; ai < 2; ++ai)
#pragma unroll
                for (int m = 0; m < 4; ++m) { const int row = row0 + ai * 128 + m * 16;
                    { const f32x4 v0 = acc[ai][0][m][0] + bv[0][0], v1 = acc[ai][0][m][1] + bv[0][1];
                      float ss = ssq8(v0, v1);
                      wsat<u32x4>(ws, (unsigned)WS_CKV + (unsigned)(row * 128 + colt) * 2u) = pack8(v0, v1);
                      ss += __shfl_xor(ss, 16); ss += __shfl_xor(ss, 32);
                      if (fq == 0) wsat<float>(ws, (unsigned)WS_KSS + (unsigned)(row * 4 + wc) * 4u) = ss; }
                    if (wc == 0) {
                        f32x4 v0 = acc[ai][1][m][0] + bv[1][0], v1 = acc[ai][1][m][1] + bv[1][1];
                        if (u.pm < 256) rope8(v0, v1, row & 4095, fq, ws);
                        const u32x4 w = pack8(v0, v1); const unsigned ko = (unsigned)WS_K + (unsigned)(krow_of(row) * QW + 64 + 8 * fq) * 2u;
#pragma unroll
                        for (int h = 0; h < NH; ++h) wsat<u32x4>(ws, ko + (unsigned)(h * DQK * 2)) = w;
                    } }
        } else {
            const int kind = (pn - 2) >> 1, cbase = ((pn - 2) & 1) * 256 + colt;
            const unsigned dbase = (unsigned)WS_SGM + (unsigned)kind * (unsigned)(WS_FIN - WS_SGM);
#pragma unroll
            for (int ai = 0; ai < 2; ++ai)
#pragma unroll
                for (int m = 0; m < 4; ++m) { const int row = row0 + ai * 128 + m * 16;
#pragma unroll
                    for (int bj = 0; bj < 2; ++bj) { f32x4 v0 = acc[ai][bj][m][0] + bv[bj][0], v1 = acc[ai][bj][m][1] + bv[bj][1];
                        if (kind != 1) { v0 = silu4(v0); v1 = silu4(v1); }
                        wsat<u32x4>(ws, dbase + (unsigned)(row * 512 + cbase + bj * 128) * 2u) = pack8(v0, v1); } }
        }
    }
};
struct EpiQ {
    static constexpr bool PERM = true;
    unsigned char* ws;
    __device__ __forceinline__ void operator()(AccRef acc, const Unit& u, int wr, int wc, int fr, int fq) const {
        const int pn = u.pn, row0 = u.pm * 256 + wr * 64 + fr, colt = wc * 32 + 8 * fq;
#pragma unroll
        for (int ai = 0; ai < 2; ++ai)
#pragma unroll
            for (int m = 0; m < 4; ++m) { const int row = row0 + ai * 128 + m * 16;
                const f32x4 q4 = wsat<f32x4>(ws, (unsigned)WS_QSS + (unsigned)row * 16u);
                const float rs = __builtin_amdgcn_rsqf(((q4[0] + q4[1]) + (q4[2] + q4[3])) * (1.f / 256.f) + LN_EPS) * C2;
#pragma unroll
                for (int bj = 0; bj < 2; ++bj) { f32x4 v0 = acc[ai][bj][m][0] * rs, v1 = acc[ai][bj][m][1] * rs;
                    if (pn < 2) { const int c = pn * 256 + bj * 128 + colt; wsat<u32x4>(ws, (unsigned)WS_Q + (unsigned)(row * QW + (c >> 6) * DQK + (c & 63)) * 2u) = pack8(v0, v1); }
                    else { rope8(v0, v1, row & 4095, fq, ws); wsat<u32x4>(ws, (unsigned)WS_Q + (unsigned)(row * QW + (4 * bj + wc) * DQK + 64 + 8 * fq) * 2u) = pack8(v0, v1); } } }
    }
};
struct EpiKV {
    static constexpr bool PERM = true;
    unsigned char* ws;
    __device__ __forceinline__ void operator()(AccRef acc, const Unit& u, int wr, int wc, int fr, int fq) const {
        const int pn = u.pn, row0 = u.pm * 256 + wr * 64 + fr, colt = wc * 32 + 8 * fq;
#pragma unroll
        for (int ai = 0; ai < 2; ++ai)
#pragma unroll
            for (int m = 0; m < 4; ++m) { const int row = row0 + ai * 128 + m * 16; const int kr = krow_of(row);
                const f32x4 q4 = wsat<f32x4>(ws, (unsigned)WS_KSS + (unsigned)row * 16u);
                const float rs = __builtin_amdgcn_rsqf(((q4[0] + q4[1]) + (q4[2] + q4[3])) * (1.f / 128.f) + LN_EPS);
#pragma unroll
                for (int bj = 0; bj < 2; ++bj) { const f32x4 v0 = acc[ai][bj][m][0] * rs, v1 = acc[ai][bj][m][1] * rs;
                    if (pn < 2) { const int c = pn * 256 + bj * 128 + colt; wsat<u32x4>(ws, (unsigned)WS_K + (unsigned)(kr * QW + (c >> 6) * DQK + (c & 63)) * 2u) = pack8(v0, v1); }
                    else { const int c = (pn - 2) * 256 + bj * 128 + colt; wsat<u32x4>(ws, (unsigned)WS_V + (unsigned)(kr * VW + c) * 2u) = pack8(v0, v1); } } }
    }
};
struct EpiF0 {
    static constexpr bool PERM = true;
    unsigned char* ws;
    __device__ __forceinline__ void operator()(AccRef acc, const Unit& u, int wr, int wc, int fr, int fq) const {
        const int bg = u.pn >> 4, bgrp = u.pn & 15;
        const unsigned base = (unsigned)WS_X + ((unsigned)((bg * 128 + wr * 64 + fr) * 64 + 4 * bgrp + (wc >> 1)) * 128u + 32u * (wc & 1) + 8u * fq) * 2u;
#pragma unroll
        for (int ai = 0; ai < 2; ++ai)
#pragma unroll
            for (int m = 0; m < 4; ++m)
#pragma unroll
                for (int bj = 0; bj < 2; ++bj)
                    wsat<u32x4>(ws, base + (unsigned)(((m * 16 * 64 + 2 * bj) * 128 + ai * 64) * 2)) = pack8(acc[ai][bj][m][0], acc[ai][bj][m][1]);
    }
};
struct EpiF1 {
    static constexpr bool PERM = true;
    unsigned char* ws;
    __device__ __forceinline__ void operator()(AccRef acc, const Unit& u, int wr, int wc, int fr, int fq) const {
        if (wr != 0) return;
        const int bg = u.pn >> 5, mq = u.pn & 31;
        const int b0 = 32 * (wc & 1) + 8 * fq;
        const unsigned base = (unsigned)WS_Y2 + ((unsigned)(((bg * 64 + fr) * 128 + 4 * mq + (wc >> 1)) * 2) * 64u + (unsigned)b0) * 2u;
        unsigned tbase = (unsigned)(fr * 64 + b0) * 4u; asm volatile("" : "+v"(tbase));
#pragma unroll
        for (int m = 0; m < 4; ++m)
#pragma unroll
            for (int n = 0; n < 2; ++n) {
                const unsigned to = tbase + (unsigned)((m * 16 * 64 + 4 * n) * 4);
                const f32x4 c = wsat<f32x4>(ws, (unsigned)WS_TWC + to), sn = wsat<f32x4>(ws, (unsigned)WS_TWS + to);
#pragma unroll
                for (int bj = 0; bj < 2; ++bj) {
                    const f32x4 re = acc[0][bj][m][n], im = acc[1][bj][m][n]; const f32x4 orr = re * c + im * sn, oi = im * c - re * sn;
                    const unsigned off = base + (unsigned)(((m * 16 * 128 + 2 * bj) * 2 * 64 + 4 * n) * 2);
                    uint2 w0, w1; w0.x = cvtpk(orr[0], orr[1]); w0.y = cvtpk(orr[2], orr[3]); w1.x = cvtpk(oi[0], oi[1]); w1.y = cvtpk(oi[2], oi[3]);
                    wsat<uint2>(ws, off) = w0; wsat<uint2>(ws, off + 128u) = w1; }
                asm volatile("" ::: "memory");
            }
    }
};
struct EpiF2 {
    static constexpr bool PERM = true;
    unsigned char* ws;
    __device__ __forceinline__ void operator()(AccRef acc, const Unit& u, int wr, int wc, int fr, int fq) const {
        if (wr != 0) return;
        const int bg = u.pn >> 5, dq = u.pn & 31, batch = bg >> 2, g = bg & 3;
#pragma unroll
        for (int m = 0; m < 4; ++m) { const int c = m * 16 + fr;
#pragma unroll
            for (int bj = 0; bj < 2; ++bj) { const int d = 2 * dq + bj, mcol0 = 32 * wc + 8 * fq;
                wsat<u32x4>(ws, (unsigned)WS_Z + (unsigned)((batch * 4096 + 64 * c + d) * 512 + 128 * g + mcol0) * 2u) = pack8(acc[0][bj][m][0], acc[0][bj][m][1]); } }
    }
};
struct EpiF3 {
    static constexpr bool PERM = true;
    unsigned char* ws; const float* bias;
    __device__ __forceinline__ void operator()(AccRef acc, const Unit& u, int wr, int wc, int fr, int fq) const {
        const int row0 = u.pm * 256 + wr * 64 + fr, col0 = u.pn * 256 + wc * 32 + 8 * fq;
        f32x4 bv[2][2];
#pragma unroll
        for (int bj = 0; bj < 2; ++bj)
#pragma unroll
            for (int n = 0; n < 2; ++n) bv[bj][n] = *(const f32x4*)(bias + col0 + bj * 128 + 4 * n);
#pragma unroll
        for (int ai = 0; ai < 2; ++ai)
#pragma unroll
            for (int m = 0; m < 4; ++m) { const int row = row0 + ai * 128 + m * 16;
#pragma unroll
                for (int bj = 0; bj < 2; ++bj) { const int c = col0 + bj * 128; const u32x4 gq = wsat<u32x4>(ws, (unsigned)WS_SGF + (unsigned)(row * 512 + c) * 2u);
                    f32x4 v0 = acc[ai][bj][m][0] + bv[bj][0], v1 = acc[ai][bj][m][1] + bv[bj][1];
                    v0 = v0 * (f32x4){bf_lo(gq.x), bf_hi(gq.x), bf_lo(gq.y), bf_hi(gq.y)}; v1 = v1 * (f32x4){bf_lo(gq.z), bf_hi(gq.z), bf_lo(gq.w), bf_hi(gq.w)};
                    wsat<u32x4>(ws, (unsigned)WS_YMIX + (unsigned)(row * 1024 + 512 + c) * 2u) = pack8(v0, v1); } }
    }
};
struct EpiOut {
    static constexpr bool PERM = false;
    unsigned char* ws; const float* bias; const float* x; float* R;
    __device__ __forceinline__ void operator()(AccRef acc, const Unit& u, int wr, int wc, int fr, int fq) const {
        const int row0 = u.pm * 256 + wr * 64 + fr, col0 = u.pn * 256 + wc * 32 + 4 * fq;
        const unsigned gate = (unsigned)WS_MOD + (unsigned)((u.pm >> 4) * 3072 + 2048 + col0) * 4u;
        f32x4 bv[2][2], gv[2][2];
#pragma unroll
        for (int bj = 0; bj < 2; ++bj)
#pragma unroll
            for (int n = 0; n < 2; ++n) { bv[bj][n] = *(const f32x4*)(bias + col0 + bj * 128 + 16 * n); gv[bj][n] = wsat<f32x4>(ws, gate + (unsigned)(bj * 128 + 16 * n) * 4u); }
#pragma unroll
        for (int ai = 0; ai < 2; ++ai)
#pragma unroll
            for (int m = 0; m < 4; ++m) { const unsigned off = (unsigned)((row0 + ai * 128 + m * 16) * 1024 + col0) * 4u;
#pragma unroll
                for (int bj = 0; bj < 2; ++bj)
#pragma unroll
                    for (int n = 0; n < 2; ++n) { const unsigned o2 = off + (unsigned)(bj * 128 + 16 * n) * 4u; const f32x4 xv = *(const f32x4*)((const unsigned char*)x + (size_t)o2);
                        *(f32x4*)((unsigned char*)R + (size_t)o2) = xv * ALPHA + gv[bj][n] * (acc[ai][bj][m][n] + bv[bj][n]); } }
    }
};

namespace att {
constexpr int KBYTES = 12288, VBYTES = 8192, BUF = KBYTES + VBYTES;
constexpr int LDS_WS = 2 * BUF, LDS_OST = LDS_WS + 8 * 256, LDS_TOTAL = LDS_OST + 8 * 4096;
constexpr int NT = SKV / 64;
__device__ __forceinline__ int crow(int r, int hi) { return (r & 3) + 8 * (r >> 2) + 4 * hi; }
__device__ __forceinline__ void attn_unit(int b, int h, int qb, const bf16_t* Q, const bf16_t* K, const bf16_t* V, const bf16_t* SGM, bf16_t* YMIX, LAS unsigned char* lds) {
    int tid_ = threadIdx.x; asm volatile("" : "+v"(tid_));
    const int tid = tid_, lane = tid & 63, r32 = lane & 31, hi = lane >> 5; const int wid = __builtin_amdgcn_readfirstlane(tid >> 6);
    const size_t krow0 = (size_t)b * SKV; const int qrow0 = b * SEQ + qb * 256 + wid * 32;
    const int kch = tid >> 6, kkey = tid & 63;
    const bf16_t* gK0 = K + (krow0 + kkey) * QW + h * DQK + kch * 8;
    const bf16_t* gK1 = gK0 + 64;
    const bf16_t* gV = V + (krow0 + ((tid >> 2) & 63)) * VW + h * DV + (tid >> 8) * 32 + (tid & 3) * 8;
    u32x4 rk0, rk1 = (u32x4){0, 0, 0, 0}, rv;
#define ATT_LOAD(t) do { rk0 = *(const u32x4*)(gK0 + (size_t)(t) * 64 * QW); if (tid < 256) rk1 = *(const u32x4*)(gK1 + (size_t)(t) * 64 * QW); rv = *(const u32x4*)(gV + (size_t)(t) * 64 * VW); } while (0)
#define ATT_WRITE(bo) do { *(LAS u32x4*)(lds + (bo) + tid * 16) = rk0; if (tid < 256) *(LAS u32x4*)(lds + (bo) + 8192 + tid * 16) = rk1; *(LAS u32x4*)(lds + (bo) + KBYTES + tid * 16) = rv; } while (0)
    ATT_LOAD(0);
    bf16x8 qr[6];
#pragma unroll
    for (int d0 = 0; d0 < 6; ++d0) qr[d0] = *(const bf16x8*)(Q + (size_t)(qrow0 + r32) * QW + h * DQK + d0 * 16 + hi * 8);
    LAS float* wsf = (LAS float*)(lds + LDS_WS) + wid * 64;
    float mrun = -1e30f, lrun = 0.f; f32x16 o[2]; o[0] = f32x16{}; o[1] = f32x16{};
    ATT_WRITE(0);
    __syncthreads();
    for (int t = 0; t < NT; ++t) {
        const int bo = (t & 1) * BUF;
        if (t + 1 < NT) ATT_LOAD(t + 1);
        f32x16 p0 = f32x16{}, p1 = f32x16{};
        { const LAS unsigned char* kp = lds + bo + hi * 1024 + r32 * 16;
#pragma unroll
          for (int d0 = 0; d0 < 6; ++d0) { const bf16x8 b0 = *(const LAS bf16x8*)(kp + d0 * 2048), b1 = *(const LAS bf16x8*)(kp + d0 * 2048 + 512);
              p0 = __builtin_amdgcn_mfma_f32_32x32x16_bf16(b0, qr[d0], p0, 0, 0, 0); p1 = __builtin_amdgcn_mfma_f32_32x32x16_bf16(b1, qr[d0], p1, 0, 0, 0); } }
        float rm = fmaxf(p0[0], p1[0]);
#pragma unroll
        for (int r = 1; r < 16; ++r) rm = fmaxf(rm, fmaxf(p0[r], p1[r]));
        rm = fmaxf(rm, __shfl_xor(rm, 32));
        if (!__all(rm <= mrun)) {
            const float mn = fmaxf(mrun, rm), al = __builtin_amdgcn_exp2f(mrun - mn); mrun = mn; lrun *= al;
            if (hi == 0) wsf[r32] = al;
            asm volatile("s_waitcnt lgkmcnt(0)" ::: "memory");
#pragma unroll
            for (int d_ = 0; d_ < 2; ++d_)
#pragma unroll
                for (int r = 0; r < 16; ++r) o[d_][r] *= wsf[crow(r, hi)];
        }
        float sacc = 0.f;
#pragma unroll
        for (int r = 0; r < 16; ++r) { p0[r] = __builtin_amdgcn_exp2f(p0[r] - mrun); p1[r] = __builtin_amdgcn_exp2f(p1[r] - mrun); sacc += p0[r] + p1[r]; }
        lrun += sacc;
        u32x4 pw[4];
#pragma unroll
        for (int i = 0; i < 4; ++i) { pw[0][i] = cvtpk(p0[2 * i], p0[2 * i + 1]); pw[1][i] = cvtpk(p0[8 + 2 * i], p0[9 + 2 * i]); pw[2][i] = cvtpk(p1[2 * i], p1[2 * i + 1]); pw[3][i] = cvtpk(p1[8 + 2 * i], p1[9 + 2 * i]); }
        { const int vb = (int)(unsigned)(uintptr_t)(lds + bo + KBYTES) + ((lane >> 4) & 1) * 32 + (lane & 3) * 8 + (4 * hi + ((lane & 15) >> 2)) * 64;
#pragma unroll
          for (int d0 = 0; d0 < 2; ++d0) { s16x4 lo[4], hh[4];
#pragma unroll
              for (int ks = 0; ks < 4; ++ks) {
                  asm volatile("ds_read_b64_tr_b16 %0,%1 offset:%c2" : "=&v"(lo[ks]) : "v"(vb), "i"(d0 * 4096 + ks * 1024) : "memory");
                  asm volatile("ds_read_b64_tr_b16 %0,%1 offset:%c2" : "=&v"(hh[ks]) : "v"(vb), "i"(d0 * 4096 + ks * 1024 + 512) : "memory"); }
              asm volatile("s_waitcnt lgkmcnt(0)" ::: "memory"); __builtin_amdgcn_sched_barrier(0);
#pragma unroll
              for (int ks = 0; ks < 4; ++ks) { const bf16x8 vf = (bf16x8){lo[ks][0], lo[ks][1], lo[ks][2], lo[ks][3], hh[ks][0], hh[ks][1], hh[ks][2], hh[ks][3]};
                  o[d0] = __builtin_amdgcn_mfma_f32_32x32x16_bf16(__builtin_bit_cast(bf16x8, pw[ks]), vf, o[d0], 0, 0, 0); } } }
        if (t + 1 < NT) ATT_WRITE(((t + 1) & 1) * BUF);
        __syncthreads();
    }
#undef ATT_LOAD
#undef ATT_WRITE
    lrun += __shfl_xor(lrun, 32);
    if (hi == 0) wsf[32 + r32] = lrun;
    asm volatile("s_waitcnt lgkmcnt(0)" ::: "memory");
    LAS bf16_t* stg = (LAS bf16_t*)(lds + LDS_OST) + wid * 2048;
#pragma unroll
    for (int r = 0; r < 16; ++r) { const int orow = crow(r, hi); const float rl = __builtin_amdgcn_rcpf(wsf[32 + orow]);
#pragma unroll
        for (int d0 = 0; d0 < 2; ++d0) stg[orow * 64 + d0 * 32 + r32] = (bf16_t)(cvtpk(o[d0][r] * rl, 0.f) & 0xffffu); }
    asm volatile("s_waitcnt lgkmcnt(0)" ::: "memory");
#pragma unroll
    for (int i = 0; i < 4; ++i) { const int row = i * 8 + (lane >> 3), ch = lane & 7; const u32x4 v = *(const LAS u32x4*)(stg + row * 64 + ch * 8);
        const size_t grow = (size_t)(qrow0 + row);
        const u32x4 g = *(const u32x4*)(SGM + grow * 512 + h * DV + ch * 8);
        u32x4 w; w.x = cvtpk(bf_lo(v.x) * bf_lo(g.x), bf_hi(v.x) * bf_hi(g.x)); w.y = cvtpk(bf_lo(v.y) * bf_lo(g.y), bf_hi(v.y) * bf_hi(g.y));
        w.z = cvtpk(bf_lo(v.z) * bf_lo(g.z), bf_hi(v.z) * bf_hi(g.z)); w.w = cvtpk(bf_lo(v.w) * bf_lo(g.w), bf_hi(v.w) * bf_hi(g.w));
        *(u32x4*)(YMIX + grow * 1024 + h * DV + ch * 8) = w; }
    __syncthreads();
}
}

__device__ __forceinline__ float cos_rev(double rev) { rev -= floor(rev); return __builtin_amdgcn_cosf((float)rev); }
__device__ __forceinline__ float sin_rev(double rev) { rev -= floor(rev); return __builtin_amdgcn_sinf((float)rev); }
__device__ __forceinline__ void transpose_item(const float* W, int K, int N, bf16_t* WT, int k0, int n0, int drow0, const float* kscale, LAS float* scr, int lane) {
#pragma unroll 8
    for (int i = 0; i < 32; ++i) { const int kk = 2 * i + (lane >> 5); float v = W[(size_t)(k0 + kk) * N + n0 + (lane & 31)]; if (kscale) v *= kscale[k0 + kk]; scr[kk * 33 + (lane & 31)] = v; }
    asm volatile("s_waitcnt lgkmcnt(0)" ::: "memory");
    const int c = lane & 7;
#pragma unroll
    for (int j = 0; j < 4; ++j) { const int n = (lane >> 3) + 8 * j; const LAS float* s = scr + (8 * c) * 33 + n;
        u32x4 o; o.x = cvtpk(s[0 * 33], s[1 * 33]); o.y = cvtpk(s[2 * 33], s[3 * 33]); o.z = cvtpk(s[4 * 33], s[5 * 33]); o.w = cvtpk(s[6 * 33], s[7 * 33]);
        *(u32x4*)(WT + (size_t)(drow0 + n) * K + k0 + 8 * c) = o; }
    asm volatile("s_waitcnt lgkmcnt(0)" ::: "memory");
}
__device__ __forceinline__ int win_drow(int j) {
    if (j < 416) return j;
    if (j < 928) return 512 + (j - 416);
    if (j < 1440) return 1024 + (j - 928);
    return 1536 + (j - 1440);
}


#define XB_TMO      128
#define XB_XCNT(j)  (256  + 64 * (j))
#define XB_XSUB(j)  (1280 + 64 * (j))
#define XB_XGEN(j)  (2304 + 64 * (j))
#define XB_TOP      3328
#define XB_TOPGEN   3392
#define XCD_BAR_WORDS 3456
#define XB_SPIN_CAP (1u << 18)
__device__ __forceinline__ unsigned xb_ld(unsigned* p)              { return __hip_atomic_load(p, __ATOMIC_RELAXED, __HIP_MEMORY_SCOPE_AGENT); }
__device__ __forceinline__ unsigned xb_add(unsigned* p, unsigned v) { return __hip_atomic_fetch_add(p, v, __ATOMIC_RELAXED, __HIP_MEMORY_SCOPE_AGENT); }
__device__ __forceinline__ unsigned xb_xcc_id() { return (unsigned)__builtin_amdgcn_s_getreg((3 << 11) | 20) & 0xFu; }
#define XB_SPIN(cond, bar) do { unsigned _sp = 0; while (cond) { __builtin_amdgcn_s_sleep(1); \
    if ((++_sp & 255u) == 0u) { if (xb_ld(&(bar)[XB_TMO])) break; if (_sp > XB_SPIN_CAP) { atomicAdd(&(bar)[XB_TMO], 1u); break; } } } } while (0)
struct XcdBarrier { unsigned* bar; unsigned x; volatile LAS unsigned* st; };
__device__ __forceinline__ XcdBarrier xcd_barrier_post(unsigned* bar, volatile LAS unsigned* st) {
    XcdBarrier b; b.bar = bar; b.x = xb_xcc_id(); b.st = st;
    if (threadIdx.x == 0) (void)xb_add(&bar[XB_XCNT(b.x)], 1u);
    return b;
}
__device__ __forceinline__ void xcd_barrier_complete(unsigned* bar, unsigned x, unsigned& nloc, unsigned& nx) {
    const unsigned G = gridDim.x * gridDim.y * gridDim.z;
    unsigned sum, cnt, mine, sp = 0u;
    for (;;) {
        sum = 0u; cnt = 0u; mine = 0u;
#pragma unroll
        for (unsigned j = 0; j < 16; ++j) { const unsigned c = xb_ld(&bar[XB_XCNT(j)]); sum += c; cnt += (c > 0u) ? 1u : 0u; mine = (j == x) ? c : mine; }
        if (sum == G) break;
        __builtin_amdgcn_s_sleep(1);
        if ((++sp & 255u) == 0u) { if (xb_ld(&bar[XB_TMO])) break; if (sp > XB_SPIN_CAP) { atomicAdd(&bar[XB_TMO], 1u); break; } }
    }
    nloc = mine > 0u ? mine : 1u; nx = cnt > 0u ? cnt : 1u;
}
__device__ __forceinline__ void xcd_barrier(const XcdBarrier& b) {
    asm volatile("s_waitcnt vmcnt(0)" ::: "memory");
    __syncthreads();
    if (threadIdx.x == 0) {
        unsigned* bar = b.bar;
        __builtin_amdgcn_s_waitcnt(0);
        unsigned nloc = b.st[0], nx = b.st[1];
        if (nloc == 0u) { xcd_barrier_complete(bar, b.x, nloc, nx); b.st[0] = nloc; b.st[1] = nx; }
        const unsigned old = xb_add(&bar[XB_XSUB(b.x)], 1u);
        const unsigned gen = old / nloc;
        if (old + 1u == (gen + 1u) * nloc) {
            __builtin_amdgcn_fence(__ATOMIC_RELEASE, "agent");
            asm volatile("s_waitcnt vmcnt(0)" ::: "memory");
            const unsigned og = xb_add(&bar[XB_TOP], 1u);
            const unsigned tg = og / nx;
            if (og + 1u == (tg + 1u) * nx) xb_add(&bar[XB_TOPGEN], 1u);
            else XB_SPIN(xb_ld(&bar[XB_TOPGEN]) == tg, bar);
            __builtin_amdgcn_fence(__ATOMIC_ACQUIRE, "agent");
            xb_add(&bar[XB_XGEN(b.x)], 1u);
            asm volatile("s_waitcnt vmcnt(0)" ::: "memory");
        } else {
            XB_SPIN(xb_ld(&bar[XB_XGEN(b.x)]) == gen, bar);
            __builtin_amdgcn_fence(__ATOMIC_ACQUIRE, "agent");
            asm volatile("s_waitcnt vmcnt(0)" ::: "memory");
        }
    }
    __syncthreads();
}

#ifndef PH_MASK
#define PH_MASK 0xFFFF
#endif
#define PH(k) ((PH_MASK >> (k)) & 1)
struct Args { const float* in[18]; float* out; unsigned char* ws; };

__global__ void __launch_bounds__(NTHR, 2) mk_fwd(Args a) {
    extern __shared__ __attribute__((aligned(16))) unsigned char lds_raw[];
    LAS unsigned char* lds = (LAS unsigned char*)lds_raw;
    cg::grid_group grid = cg::this_grid();
    const int tid = threadIdx.x, lane = tid & 63, wave = __builtin_amdgcn_readfirstlane(tid >> 6);
    const int G = gridDim.x, bx = blockIdx.x;
    const int vcu = (G % 8 == 0) ? (bx % 8) * (G / 8) + bx / 8 : bx;
    const int gw = bx * 8 + wave, NGW = G * 8;
    volatile LAS unsigned* MISC = (volatile LAS unsigned*)(lds + 131072 + 320);
    if (tid < 32) MISC[tid] = 0u;
    __syncthreads();
#define KARGS() ([]() __attribute__((always_inline)) { const __attribute__((address_space(4))) Args* p_ = (const __attribute__((address_space(4))) Args*)__builtin_amdgcn_kernarg_segment_ptr(); asm volatile("" : "+s"(p_)); return p_; }())
#define WS() ((unsigned char*)KARGS()->ws)
#define INP(i) ((const float*)KARGS()->in[i])
    const XcdBarrier xbar = xcd_barrier_post((unsigned*)WS(), MISC + 8);
#define GRID_BAR() xcd_barrier(xbar)
    if (PH(0)) {
    unsigned char* ws = WS();
    if (bx < 192) {
        const float *cvec = INP(1), *c_ctx = INP(3), *w_ada = INP(4), *b_ada = INP(5);
        float* MOD = (float*)(ws + WS_MOD);
        LAS float* S = (LAS float*)lds;
        LAS float* red = S + 17 * 1024;
        for (int i = tid; i < 17 * 1024; i += NTHR) { const float v = i < 16 * 1024 ? cvec[i] : c_ctx[i - 16 * 1024]; S[i] = v / (1.f + __expf(-v)); }
        __syncthreads();
        const int col = tid & 15, ks = tid >> 4, col0 = bx * 16;
        float acc[17];
#pragma unroll
        for (int r = 0; r < 17; ++r) acc[r] = 0.f;
        for (int k = ks; k < 1024; k += 32) { const float w = w_ada[(size_t)k * 3072 + col0 + col];
#pragma unroll
            for (int r = 0; r < 17; ++r) acc[r] += S[r * 1024 + k] * w; }
#pragma unroll
        for (int r = 0; r < 17; ++r) red[(ks * 17 + r) * 16 + col] = acc[r];
        __syncthreads();
        if (tid < 272) { const int r = tid >> 4, cc = tid & 15; float s = 0.f;
            for (int k2 = 0; k2 < 32; ++k2) s += red[(k2 * 17 + r) * 16 + cc];
            MOD[r * 3072 + col0 + cc] = s + b_ada[col0 + cc]; }
        __syncthreads();
    }
    {
        LAS float* scr = (LAS float*)(lds + wave * 16384);
        constexpr int I_IN = 16 * 61, I_Q = 4 * 24, I_KV = 2 * 32, I_F = 8 * 16, I_O = 16 * 32, NITEMS = I_IN + I_Q + I_KV + I_F + I_O;
        for (int it = gw; it < NITEMS; it += NGW) {
            int r = it;
            if (r < I_IN) { const int kb = r / 61, nb = r % 61; transpose_item(INP(6), 1024, 1952, (bf16_t*)(ws + WS_WIN), 64 * kb, 32 * nb, win_drow(32 * nb), nullptr, scr, lane); continue; } r -= I_IN;
            if (r < I_Q) { const int kb = r / 24, nb = r % 24, hh = nb / 3, part = nb % 3; const int dr = part < 2 ? hh * 64 + part * 32 : 512 + hh * 32;
                transpose_item(INP(9), 256, 768, (bf16_t*)(ws + WS_WQ), 64 * kb, 32 * nb, dr, INP(8), scr, lane); continue; } r -= I_Q;
            if (r < I_KV) { const int kb = r / 32, nb = r % 32, hh = nb / 4, part = nb % 4; const int dr = part < 2 ? hh * 64 + part * 32 : 512 + hh * 64 + (part - 2) * 32;
                transpose_item(INP(11), 128, 1024, (bf16_t*)(ws + WS_WKV), 64 * kb, 32 * nb, dr, INP(10), scr, lane); continue; } r -= I_KV;
            if (r < I_F) { const int kb = r / 16, nb = r % 16; transpose_item(INP(12), 512, 512, (bf16_t*)(ws + WS_WF), 64 * kb, 32 * nb, 32 * nb, nullptr, scr, lane); continue; } r -= I_F;
            { const int kb = r / 32, nb = r % 32; transpose_item(INP(14), 1024, 1024, (bf16_t*)(ws + WS_WO), 64 * kb, 32 * nb, 32 * nb, nullptr, scr, lane); }
        }
    }
    {
        float* ropeC = (float*)(ws + WS_ROPEC); float* ropeS = (float*)(ws + WS_ROPES);
        float* TWC = (float*)(ws + WS_TWC); float* TWS = (float*)(ws + WS_TWS); float* BIN2 = (float*)(ws + WS_BIN2);
        bf16_t *FcT = (bf16_t*)(ws + WS_FC), *G1 = (bf16_t*)(ws + WS_G1), *G2 = (bf16_t*)(ws + WS_G2), *WinT = (bf16_t*)(ws + WS_WIN);
        const float* b_in = INP(7);
        const int gt = bx * NTHR + tid, NT_ = G * NTHR;
        const double INV2PI = 0.15915494309189535;
        for (int i = gt; i < 4096 * 16; i += NT_) { const int pos = i >> 4, aa = i & 15; const int comp = aa < 8 ? (pos >> 6) : (pos & 63); const int fi = aa & 7;
            const double invf = fi == 0 ? 1.0 : fi == 1 ? 0.31622776601683794 : fi == 2 ? 0.1 : fi == 3 ? 0.031622776601683794 : fi == 4 ? 0.01 : fi == 5 ? 0.0031622776601683794 : fi == 6 ? 0.001 : 0.00031622776601683794;
            const double rev = (double)comp * invf * INV2PI; ropeC[i] = cos_rev(rev); ropeS[i] = sin_rev(rev); }
        for (int i = gt; i < 4096; i += NT_) { const int d = i >> 6, b = i & 63; const double rev = (double)((b * d) & 4095) / 4096.0; TWC[i] = cos_rev(rev); TWS[i] = sin_rev(rev); }
        for (int i = gt; i < 256 * 128; i += NT_) { const int r = i >> 7, kk = i & 127;
            { const int part = r >> 7, mc = r & 127; const double rev = (double)((kk * mc) & 127) / 128.0; const float v = part == 0 ? cos_rev(rev) : -sin_rev(rev); FcT[i] = (bf16_t)(cvtpk(v, 0.f) & 0xffffu); }
            { const int ai = r >> 7, q = r & 127, part = kk >> 6, aa = kk & 63; float v = 0.f;
              if (q < 64) { const double rev = (double)((aa * q) & 63) / 64.0; v = ai == 0 ? (part == 0 ? cos_rev(rev) : sin_rev(rev)) : (part == 0 ? -sin_rev(rev) : cos_rev(rev)); }
              G1[i] = (bf16_t)(cvtpk(v, 0.f) & 0xffffu); }
            { const int part = kk >> 6, bb = kk & 63; float v = 0.f;
              if (r < 64) { const double rev = (double)((bb * r) & 63) / 64.0; v = (part == 0 ? cos_rev(rev) : sin_rev(rev)) * FNORM; }
              G2[i] = (bf16_t)(cvtpk(v, 0.f) & 0xffffu); } }
        for (int i = gt; i < 2048; i += NT_) { float v = 0.f;
            if (i < 416) v = b_in[i]; else if (i >= 512 && i < 1024) v = b_in[416 + (i - 512)]; else if (i >= 1024 && i < 1536) v = b_in[928 + (i - 1024)]; else if (i >= 1536) v = b_in[1440 + (i - 1536)];
            BIN2[i] = v; }
        for (int i = gt; i < 96 * 1024 / 8; i += NT_) *(u32x4*)(WinT + (size_t)416 * 1024 + (size_t)i * 8) = (u32x4){0, 0, 0, 0};
    }
    }
    grid.sync();

    if (PH(1)) {
    unsigned char* ws = WS(); const float *x = INP(0), *ctx = INP(2);
    const float* MOD = (const float*)(ws + WS_MOD); bf16_t* XN = (bf16_t*)(ws + WS_XN);
    for (int m = gw; m < NROW; m += NGW) {
        const float* src = m < NLAT ? x + (size_t)m * DM : ctx + (size_t)(m - NLAT) * DM;
        const float* mod = MOD + (size_t)(m < NLAT ? (m >> 12) : 16) * 3072;
        const f32x4* xr = (const f32x4*)src + lane;
        f32x4 v[4]; float s = 0.f;
#pragma unroll
        for (int j = 0; j < 4; ++j) { v[j] = xr[64 * j]; s += (v[j][0] + v[j][1]) + (v[j][2] + v[j][3]); }
        const float mean = wave_sum(s) * (1.f / DM); float s2 = 0.f;
#pragma unroll
        for (int j = 0; j < 4; ++j) { v[j] = v[j] - mean; s2 += (v[j][0] * v[j][0] + v[j][1] * v[j][1]) + (v[j][2] * v[j][2] + v[j][3] * v[j][3]); }
        const float rstd = 1.f / sqrtf(wave_sum(s2) * (1.f / DM) + LN_EPS);
        uint2* o8 = (uint2*)(XN + (size_t)m * DM) + lane;
#pragma unroll
        for (int j = 0; j < 4; ++j) { const f32x4 sh = ((const f32x4*)mod)[lane + 64 * j], sc = ((const f32x4*)(mod + 1024))[lane + 64 * j];
            const f32x4 hv = v[j] * rstd * (sc + 1.f) + sh; uint2 w; w.x = cvtpk(hv[0], hv[1]); w.y = cvtpk(hv[2], hv[3]); o8[64 * j] = w; }
    }
    }
    GRID_BAR();

    if (PH(2)) {
        unsigned char* ws = WS();
        pg8::ProbRM P{(const bf16_t*)(ws + WS_XN), (const bf16_t*)(ws + WS_WIN), 1024, 1024, 16};
        pg8::GridOrder S; S.init(256, 8, G, bx, 16, 1);
        EpiIn E{ws};
        pg8::gemm_phase(lds, P, S, E);
    }
    GRID_BAR();

    if (PH(3)) {
        unsigned char* ws = WS();
        pg8::ProbRM P{(const bf16_t*)(ws + WS_QLAT), (const bf16_t*)(ws + WS_WQ), 256, 256, 4}; pg8::GridOrder S; S.init(256, 3, G, bx);
        EpiQ E{ws};
        pg8::gemm_phase(lds, P, S, E);
    }
    if (PH(4)) {
        unsigned char* ws = WS();
        pg8::ProbRM P{(const bf16_t*)(ws + WS_CKV), (const bf16_t*)(ws + WS_WKV), 128, 128, 2}; pg8::GridOrder S; S.init(272, 4, G, bx);
        EpiKV E{ws};
        pg8::gemm_phase(lds, P, S, E);
    }
    if (PH(5)) {
        unsigned char* ws = WS();
        pg8::ProbF0 P{(const bf16_t*)(ws + WS_FC), (const bf16_t*)(ws + WS_FIN), 2}; pg8::LinOrder S; S.init(1024, G, bx);
        EpiF0 E{ws};
        pg8::gemm_phase(lds, P, S, E);
    }
    GRID_BAR();

    if (PH(6)) {
        unsigned char* ws = WS();
        pg8::ProbRM P{(const bf16_t*)(ws + WS_G1), (const bf16_t*)(ws + WS_X), 128, 128, 2}; pg8::LinOrder S; S.init(2048, G, bx);
        EpiF1 E{ws};
        pg8::gemm_phase(lds, P, S, E);
    }
    GRID_BAR();

    if (PH(7)) {
        unsigned char* ws = WS();
        pg8::ProbRM P{(const bf16_t*)(ws + WS_G2), (const bf16_t*)(ws + WS_Y2), 128, 128, 2}; pg8::LinOrder S; S.init(2048, G, bx);
        EpiF2 E{ws};
        pg8::gemm_phase(lds, P, S, E);
    }
    GRID_BAR();

#ifndef NO_ATT
    if (PH(8)) {
    unsigned char* ws = WS();
    for (int i = 0;; ++i) { const int L = i * G + vcu; if (L >= 2048) break; const int bh = L >> 4, qb = L & 15;
        att::attn_unit(bh >> 3, bh & 7, qb, (const bf16_t*)(ws + WS_Q), (const bf16_t*)(ws + WS_K), (const bf16_t*)(ws + WS_V), (const bf16_t*)(ws + WS_SGM), (bf16_t*)(ws + WS_YMIX), lds); }
    }
#else
    { bf16_t* YMIX = (bf16_t*)(WS() + WS_YMIX);
    for (int m = gw; m < NLAT; m += NGW) *(u32x4*)(YMIX + (size_t)m * 1024 + lane * 8) = (u32x4){0, 0, 0, 0}; }
#endif
    if (PH(9)) {
        unsigned char* ws = WS();
        pg8::ProbRM P{(const bf16_t*)(ws + WS_Z), (const bf16_t*)(ws + WS_WF), 512, 512, 8}; pg8::GridOrder S; S.init(256, 2, G, bx);
        EpiF3 E{ws, INP(13)};
        pg8::gemm_phase(lds, P, S, E);
    }
    GRID_BAR();

    if (PH(10)) {
        unsigned char* ws = WS();
        pg8::ProbRM P{(const bf16_t*)(ws + WS_YMIX), (const bf16_t*)(ws + WS_WO), 1024, 1024, 16}; pg8::GridOrder S; S.init(256, 4, G, bx);
        EpiOut E{ws, INP(15), INP(0), (float*)KARGS()->out};
        pg8::gemm_phase(lds, P, S, E);
    }
    GRID_BAR();

    if (PH(11)) {
    float* outp = (float*)KARGS()->out; const float *post_g = INP(16), *post_b = INP(17);
    for (int m = gw; m < NLAT; m += NGW) {
        f32x4* xr = (f32x4*)(outp + (size_t)m * DM) + lane;
        f32x4 v[4]; float s = 0.f;
#pragma unroll
        for (int j = 0; j < 4; ++j) { v[j] = xr[64 * j]; s += (v[j][0] + v[j][1]) + (v[j][2] + v[j][3]); }
        const float mean = wave_sum(s) * (1.f / DM); float s2 = 0.f;
#pragma unroll
        for (int j = 0; j < 4; ++j) { v[j] = v[j] - mean; s2 += (v[j][0] * v[j][0] + v[j][1] * v[j][1]) + (v[j][2] * v[j][2] + v[j][3] * v[j][3]); }
        const float rstd = 1.f / sqrtf(wave_sum(s2) * (1.f / DM) + LN_EPS);
#pragma unroll
        for (int j = 0; j < 4; ++j) { const f32x4 gg = ((const f32x4*)post_g)[lane + 64 * j], b4 = ((const f32x4*)post_b)[lane + 64 * j]; xr[64 * j] = v[j] * rstd * gg + b4; }
    }
    }
}

extern "C" void kernel_launch(void* const* d_in, const int* in_sizes, int n_in, void* d_out, int out_size, void* d_ws, size_t ws_size, hipStream_t stream) {
    static int grid = 0;
    if (grid == 0) {
        if (n_in != 18 || out_size != NLAT * DM || ws_size < WS_END) { fprintf(stderr, "kernel_launch: unexpected shapes: n_in %d out %d ws %zu (need %zu)\n", n_in, out_size, ws_size, (size_t)WS_END); grid = -1; return; }
        int dev = 0, cus = 0, per_cu = 0;
        (void)hipGetDevice(&dev);
        (void)hipDeviceGetAttribute(&cus, hipDeviceAttributeMultiprocessorCount, dev);
        (void)hipFuncSetAttribute((const void*)mk_fwd, hipFuncAttributeMaxDynamicSharedMemorySize, LDS_BYTES);
        (void)hipOccupancyMaxActiveBlocksPerMultiprocessor(&per_cu, (const void*)mk_fwd, NTHR, LDS_BYTES);
        if (per_cu < 1) { fprintf(stderr, "kernel_launch: occupancy query reports %d blocks/CU\n", per_cu); grid = -1; return; }
        grid = cus;
    }
    if (grid < 0) return;
    (void)hipMemsetAsync(d_ws, 0, 65536, stream);
    Args a{};
    for (int i = 0; i < 18; ++i) a.in[i] = (const float*)d_in[i];
    a.out = (float*)d_out; a.ws = (unsigned char*)d_ws;
    void* args[] = {&a};
    hipError_t e = hipLaunchCooperativeKernel((const void*)mk_fwd, dim3(grid), dim3(NTHR), args, LDS_BYTES, stream);
    if (e != hipSuccess) fprintf(stderr, "cooperative launch failed: %s (grid %d)\n", hipGetErrorString(e), grid);
}
```

```cpp
#include <hip/hip_runtime.h>
#include <hip/hip_cooperative_groups.h>
#include <cstdio>
#include <cstdint>
namespace cg = cooperative_groups;

#define LAS __attribute__((address_space(3)))
typedef unsigned short bf16_t;
typedef short bf16x8 __attribute__((ext_vector_type(8)));
typedef short s16x4 __attribute__((ext_vector_type(4)));
typedef float f32x4 __attribute__((ext_vector_type(4)));
typedef float f32x16 __attribute__((ext_vector_type(16)));
typedef unsigned u32x4 __attribute__((ext_vector_type(4)));
typedef float f32x2_t __attribute__((ext_vector_type(2)));
typedef __bf16 bf16x2_t __attribute__((ext_vector_type(2)));

constexpr int NTHR = 512;
constexpr int LDS_BYTES = 147456;
constexpr int DM = 1024, BATCH = 16, SEQ = 4096, CTX = 256, NLAT = BATCH * SEQ  , NCTX = BATCH * CTX  , NROW = NLAT + NCTX  ;
constexpr int SKV = CTX + SEQ;
constexpr int NH = 8, DQK = 96, DV = 64, QW = NH * DQK  , VW = NH * DV  ;
constexpr float LN_EPS = 1e-6f;
constexpr float ALPHA = 1.189207115002721f;
constexpr float C2 = 1.4426950408889634f * 0.10206207261596577f;
constexpr float FNORM = 0.0013810679320049757f;

constexpr size_t MiB = 1u << 20;
constexpr size_t WS_MOD = 1 * MiB;
constexpr size_t WS_ROPEC = 2 * MiB, WS_ROPES = 2 * MiB + 262144;
constexpr size_t WS_TWC = 2 * MiB + 524288, WS_TWS = WS_TWC + 16384;
constexpr size_t WS_BIN2 = WS_TWS + 16384;
constexpr size_t WS_WIN = 4 * MiB;
constexpr size_t WS_WO = 8 * MiB;
constexpr size_t WS_WQ = 10 * MiB;
constexpr size_t WS_WKV = 10 * MiB + 524288;
constexpr size_t WS_WF = 11 * MiB;
constexpr size_t WS_FC = 11 * MiB + 524288;
constexpr size_t WS_G1 = WS_FC + 65536, WS_G2 = WS_G1 + 65536;
constexpr size_t WS_QSS = 12 * MiB;
constexpr size_t WS_KSS = 13 * MiB;
constexpr size_t WS_XN = 16 * MiB;
constexpr size_t WS_X = WS_XN;
constexpr size_t WS_QLAT = 152 * MiB;
constexpr size_t WS_CKV = 184 * MiB;
constexpr size_t WS_SGM = 202 * MiB;
constexpr size_t WS_FIN = 266 * MiB;
constexpr size_t WS_SGF = 330 * MiB;
constexpr size_t WS_Q = 394 * MiB;
constexpr size_t WS_K = 490 * MiB;
constexpr size_t WS_V = 592 * MiB;
constexpr size_t WS_Y2 = 660 * MiB;
constexpr size_t WS_Z = 788 * MiB;
constexpr size_t WS_YMIX = 852 * MiB;
constexpr size_t WS_END = 980 * MiB;
static_assert(WS_SGF - WS_FIN == WS_FIN - WS_SGM, "SGM|FIN|SGF equally spaced");

__device__ __forceinline__ float wave_sum(float v) {
#pragma unroll
    for (int o = 1; o < 64; o <<= 1) v += __shfl_xor(v, o);
    return v;
}
__device__ __forceinline__ unsigned cvtpk(float lo, float hi) { f32x2_t v = {lo, hi}; bf16x2_t b = __builtin_convertvector(v, bf16x2_t); return __builtin_bit_cast(unsigned, b); }
__device__ __forceinline__ u32x4 pack8(const f32x4& a, const f32x4& b) { u32x4 w; w.x = cvtpk(a[0], a[1]); w.y = cvtpk(a[2], a[3]); w.z = cvtpk(b[0], b[1]); w.w = cvtpk(b[2], b[3]); return w; }
__device__ __forceinline__ float bf_lo(unsigned u) { return __uint_as_float(u << 16); }
__device__ __forceinline__ float bf_hi(unsigned u) { return __uint_as_float(u & 0xffff0000u); }
__device__ __forceinline__ float silu_f(float v) { return v * __builtin_amdgcn_rcpf(1.f + __expf(-v)); }
__device__ __forceinline__ f32x4 silu4(const f32x4& v) { return (f32x4){silu_f(v[0]), silu_f(v[1]), silu_f(v[2]), silu_f(v[3])}; }

namespace pg8 {
constexpr int BM = 256, BK = 64, HALF = 128, HTB = HALF * BK * 2, STAGE_BYTES = 8 * HTB, NXCD = 8, WGM = 8;
__device__ __forceinline__ int lds_byte(int r, int c) { const int st = (r >> 4) * 2 + (c >> 5), rr = r & 15, cc = c & 31, ob = rr * 64 + cc * 2; return st * 1024 + (ob ^ (((ob >> 9) & 1) << 5)); }
__device__ __forceinline__ void stage_rc(int b, int& R, int& C) { const int st = b / 1024, sb = b % 1024, swz = sb ^ (((sb >> 9) & 1) << 5); R = (st >> 1) * 16 + swz / 64; C = (st & 1) * 32 + (swz % 64) / 2; }
__device__ __forceinline__ int perm32(int rho) { const int n = rho >> 4, i = rho & 15; return 8 * (i >> 2) + 4 * n + (i & 3); }
struct Unit { int pm, pn; };

struct GridOrder {
    int nM, nN, nwg, G, c, extra, extra_pn;
    __device__ void init(int nM_, int nN_, int G_, int c_, int extra_ = 0, int extra_pn_ = 0) { nM = nM_; nN = nN_; nwg = nM * nN; G = G_; c = c_; extra = extra_; extra_pn = extra_pn_; }
    __device__ bool next(int i, Unit& u) const {
        const long L = (long)i * G + c;
        if (L >= nwg) { if (L < nwg + extra) { u.pm = nM + (int)(L - nwg); u.pn = extra_pn; return true; } return false; }
        int wgid = (int)L; { const int q = nwg / NXCD, r = nwg % NXCD, xcd = wgid % NXCD, off = wgid / NXCD; wgid = (xcd < r ? xcd * (q + 1) : r * (q + 1) + (xcd - r) * q) + off; }
        const int nig = WGM * nN, gid = wgid / nig, fm = gid * WGM, gsz = (nM - fm) < WGM ? (nM - fm) : WGM;
        u.pm = fm + ((wgid % nig) % gsz); u.pn = (wgid % nig) / gsz; return true;
    }
};
struct LinOrder {
    int n, G, c;
    __device__ void init(int n_, int G_, int c_) { n = n_; G = G_; c = c_; }
    __device__ bool next(int i, Unit& u) const { const long L = (long)i * G + c; if (L >= n) return false; u.pm = 0; u.pn = (int)L; return true; }
};

struct ProbRM {
    const bf16_t* A; const bf16_t* Bt; int lda, ldb, nt;
    __device__ __forceinline__ unsigned offA(int R, int C) const { return (unsigned)(R * lda + C) * 2u; }
    __device__ __forceinline__ unsigned offB(int R, int C) const { return (unsigned)(R * ldb + C) * 2u; }
    __device__ __forceinline__ size_t hstepA() const { return (size_t)HALF * lda * 2; }
    __device__ __forceinline__ size_t hstepB() const { return (size_t)HALF * ldb * 2; }
    __device__ __forceinline__ const char* baseA(const Unit& u) const { return (const char*)A + (size_t)u.pm * BM * lda * 2; }
    __device__ __forceinline__ const char* baseB(const Unit& u) const { return (const char*)Bt + (size_t)u.pn * BM * ldb * 2; }
};
struct ProbF0 {
    const bf16_t* A; const bf16_t* FIN; int nt;
    __device__ __forceinline__ unsigned offA(int R, int C) const { return (unsigned)(R * 128 + C) * 2u; }
    __device__ __forceinline__ unsigned offB(int R, int C) const { return (unsigned)((64 * (R & 63) + (R >> 6)) * 512 + C) * 2u; }
    __device__ __forceinline__ size_t hstepA() const { return (size_t)HALF * 128 * 2; }
    __device__ __forceinline__ size_t hstepB() const { return (size_t)2 * 512 * 2; }
    __device__ __forceinline__ const char* baseA(const Unit&) const { return (const char*)A; }
    __device__ __forceinline__ const char* baseB(const Unit& u) const { const int bg = u.pn >> 4, bgrp = u.pn & 15, batch = bg >> 2, g = bg & 3; return (const char*)FIN + ((size_t)(batch * 4096 + 4 * bgrp) * 512 + 128 * g) * 2; }
};

template <class Prob, class Epi, class Sched>
__device__ __forceinline__ void gemm_phase(LAS unsigned char* lds, const Prob& P, const Sched& S, const Epi& E) {
    int tid_ = threadIdx.x; asm volatile("" : "+v"(tid_));
    const int tid = tid_, wid = __builtin_amdgcn_readfirstlane(tid >> 6), lane = tid & 63, wr = wid >> 2, wc = wid & 3, fr = lane & 15, fq = lane >> 4;
    const int nt = P.nt;
    unsigned voffA[2], voffB[2];
#pragma unroll
    for (int i = 0; i < 2; ++i) { int R, C; stage_rc(tid * 16 + i * 8192, R, C); const int Rb = Epi::PERM ? ((R & ~31) + perm32(R & 31)) : R;
        voffA[i] = P.offA(R, C); voffB[i] = P.offB(Rb, C); }
    const size_t kstep = (size_t)(BK * 2);
    const size_t hstepA = P.hstepA(), hstepB = P.hstepB();
    const unsigned ldsw = (unsigned)wid * 1024u;
    const int aoff = lds_byte(wr * 64 + fr, fq * 8), boff = lds_byte(wc * 32 + fr, fq * 8);
#define PG8_SA(b, h) (((b) * 2 + (h)) * HTB)
#define PG8_SB(b, h) ((4 + (b) * 2 + (h)) * HTB)
#define PG8_STAGE(bufoff, gbase, voff) do { _Pragma("unroll") for (int _i = 0; _i < 2; ++_i) \
        __builtin_amdgcn_global_load_lds((const unsigned*)((const char*)(gbase) + (voff)[_i]), (LAS unsigned*)(lds + (bufoff) + ldsw + _i * 8192), 16, 0, 0); } while (0)
#define PG8_LDA(dst, b, h) do { _Pragma("unroll") for (int m = 0; m < 4; ++m) _Pragma("unroll") for (int k = 0; k < 2; ++k) dst[m][k] = *(const LAS bf16x8*)(lds + PG8_SA(b, h) + aoff + m * 2048 + k * 1024); } while (0)
#define PG8_LDB(dst, b, h) do { _Pragma("unroll") for (int n = 0; n < 2; ++n) _Pragma("unroll") for (int k = 0; k < 2; ++k) dst[n][k] = *(const LAS bf16x8*)(lds + PG8_SB(b, h) + boff + n * 2048 + k * 1024); } while (0)
#define PG8_MMA(ai, bj, At, Bt) do { __builtin_amdgcn_s_setprio(1); _Pragma("unroll") for (int m = 0; m < 4; ++m) _Pragma("unroll") for (int n = 0; n < 2; ++n) _Pragma("unroll") for (int k = 0; k < 2; ++k) \
        acc[ai][bj][m][n] = __builtin_amdgcn_mfma_f32_16x16x32_bf16(Bt[n][k], At[m][k], acc[ai][bj][m][n], 0, 0, 0); __builtin_amdgcn_s_setprio(0); } while (0)
#define PG8_WAIT_V(n) asm volatile("s_waitcnt vmcnt(" #n ")" ::: "memory")
#define PG8_WAIT_L(n) asm volatile("s_waitcnt lgkmcnt(" #n ")" ::: "memory")
#define PG8_BAR __builtin_amdgcn_s_barrier()
#define PG8_SCHED __builtin_amdgcn_sched_barrier(0)
    Unit cur, nxt; int ui = 0;
    if (!S.next(0, cur)) return;
    f32x4 acc[2][2][4][2];
#pragma unroll
    for (int a = 0; a < 2; ++a)
#pragma unroll
        for (int b = 0; b < 2; ++b)
#pragma unroll
            for (int m = 0; m < 4; ++m)
#pragma unroll
                for (int n = 0; n < 2; ++n) acc[a][b][m][n] = (f32x4){0.f, 0.f, 0.f, 0.f};
    bf16x8 At[4][2], B0[2][2], B1[2][2];
    const char* cA = P.baseA(cur); const char* cB = P.baseB(cur);
    PG8_STAGE(PG8_SB(0, 0), cB, voffB); PG8_STAGE(PG8_SB(0, 1), cB + hstepB, voffB); PG8_STAGE(PG8_SA(0, 0), cA, voffA); PG8_STAGE(PG8_SA(0, 1), cA + hstepA, voffA);
    if (wr == 1) PG8_BAR;
    PG8_WAIT_V(2); PG8_BAR;
    PG8_STAGE(PG8_SB(1, 0), cB + kstep, voffB); PG8_STAGE(PG8_SA(1, 0), cA + kstep, voffA); PG8_STAGE(PG8_SB(1, 1), cB + hstepB + kstep, voffB);
    PG8_WAIT_V(6); PG8_BAR;
    for (;;) {
        const bool has_next = S.next(ui + 1, nxt);
        const char* nA = has_next ? P.baseA(nxt) : cA; const char* nB = has_next ? P.baseB(nxt) : cB;
        for (int t = 0; t < nt; t += 2) {
            const bool last = (t == nt - 2);
            const char* a1 = cA + (size_t)(t + 1) * kstep;
            const char* a2 = last ? nA : cA + (size_t)(t + 2) * kstep; const char* b2 = last ? nB : cB + (size_t)(t + 2) * kstep;
            const char* a3 = a2 + kstep; const char* b3 = b2 + kstep;
            asm volatile("" : "+s"(a1), "+s"(a2), "+s"(b2), "+s"(a3), "+s"(b3));
            PG8_LDB(B0, 0, 0); PG8_LDB(B1, 0, 1); PG8_SCHED; PG8_LDA(At, 0, 0); PG8_STAGE(PG8_SA(1, 1), a1 + hstepA, voffA);
            PG8_WAIT_V(8); PG8_WAIT_L(0); PG8_BAR; PG8_MMA(0, 0, At, B0); PG8_MMA(0, 1, At, B1); PG8_BAR; PG8_SCHED;
            PG8_LDA(At, 0, 1); PG8_STAGE(PG8_SB(0, 0), b2, voffB); PG8_STAGE(PG8_SB(0, 1), b2 + hstepB, voffB); PG8_STAGE(PG8_SA(0, 0), a2, voffA);
            PG8_WAIT_V(8); PG8_WAIT_L(0); PG8_BAR; PG8_MMA(1, 0, At, B0); PG8_MMA(1, 1, At, B1); PG8_BAR; PG8_SCHED;
            PG8_LDB(B0, 1, 0); PG8_LDB(B1, 1, 1); PG8_SCHED; PG8_LDA(At, 1, 0); PG8_STAGE(PG8_SA(0, 1), a2 + hstepA, voffA);
            PG8_WAIT_V(8); PG8_WAIT_L(0); PG8_BAR; PG8_MMA(0, 0, At, B0); PG8_MMA(0, 1, At, B1); PG8_BAR; PG8_SCHED;
            PG8_LDA(At, 1, 1); PG8_STAGE(PG8_SB(1, 0), b3, voffB); PG8_STAGE(PG8_SB(1, 1), b3 + hstepB, voffB); PG8_STAGE(PG8_SA(1, 0), a3, voffA);
            PG8_WAIT_V(8); PG8_WAIT_L(0); PG8_BAR; PG8_MMA(1, 0, At, B0); PG8_MMA(1, 1, At, B1); PG8_BAR; PG8_SCHED;
        }
        if (wr == 0) PG8_BAR;
        E(acc, cur, wr, wc, fr, fq);
        if (!has_next) break;
#pragma unroll
        for (int a = 0; a < 2; ++a)
#pragma unroll
            for (int b = 0; b < 2; ++b)
#pragma unroll
                for (int m = 0; m < 4; ++m)
#pragma unroll
                    for (int n = 0; n < 2; ++n) acc[a][b][m][n] = (f32x4){0.f, 0.f, 0.f, 0.f};
        cur = nxt; cA = nA; cB = nB; ++ui;
        if (wr == 1) PG8_BAR;
    }
    PG8_WAIT_V(0);
    PG8_BAR;
#undef PG8_SA
#undef PG8_SB
#undef PG8_STAGE
#undef PG8_LDA
#undef PG8_LDB
#undef PG8_MMA
#undef PG8_WAIT_V
#undef PG8_WAIT_L
#undef PG8_BAR
#undef PG8_SCHED
}
}
using pg8::Unit;
typedef const f32x4 (&AccRef)[2][2][4][2];

template <class T> __device__ __forceinline__ T& wsat(unsigned char* ws, unsigned off) { return *(T*)(ws + (size_t)off); }
static_assert(WS_END < (4096ull << 20), "32-bit workspace offsets");
__device__ __forceinline__ void rope8(f32x4& v0, f32x4& v1, int pos, int fq, unsigned char* ws) {
    const unsigned o = (unsigned)(pos * 16 + 8 * (fq & 1)) * 4u;
    const f32x4 c0 = wsat<f32x4>(ws, (unsigned)WS_ROPEC + o), c1 = wsat<f32x4>(ws, (unsigned)WS_ROPEC + o + 16u);
    const f32x4 s0 = wsat<f32x4>(ws, (unsigned)WS_ROPES + o), s1 = wsat<f32x4>(ws, (unsigned)WS_ROPES + o + 16u);
    const float sg = (fq < 2) ? -1.f : 1.f;
#pragma unroll
    for (int e = 0; e < 4; ++e) {
        const float p0 = __shfl_xor(v0[e], 32), p1 = __shfl_xor(v1[e], 32);
        v0[e] = v0[e] * c0[e] + sg * p0 * s0[e];
        v1[e] = v1[e] * c1[e] + sg * p1 * s1[e];
    }
}
__device__ __forceinline__ int krow_of(int row) {
    if (row < NLAT) return (row >> 12) * SKV + CTX + (row & 4095);
    const int r = row - NLAT; return (r >> 8) * SKV + (r & 255);
}
__device__ __forceinline__ float ssq8(const f32x4& v0, const f32x4& v1) { return (v0[0] * v0[0] + v0[1] * v0[1]) + (v0[2] * v0[2] + v0[3] * v0[3]) + (v1[0] * v1[0] + v1[1] * v1[1]) + (v1[2] * v1[2] + v1[3] * v1[3]); }

struct EpiIn {
    static constexpr bool PERM = true;
    unsigned char* ws;
    __device__ __forceinline__ void operator()(AccRef acc, const Unit& u, int wr, int wc, int fr, int fq) const {
        const int pn = u.pn, row0 = u.pm * 256 + wr * 64 + fr, colt = wc * 32 + 8 * fq;
        f32x4 bv[2][2];
#pragma unroll
        for (int bj = 0; bj < 2; ++bj)
#pragma unroll
            for (int n = 0; n < 2; ++n) bv[bj][n] = wsat<f32x4>(ws, (unsigned)WS_BIN2 + (unsigned)(pn * 256 + bj * 128 + colt + 4 * n) * 4u);
        if (pn == 0) {
#pragma unroll
            for (int ai = 0; ai < 2; ++ai)
#pragma unroll
                for (int m = 0; m < 4; ++m) { const int row = row0 + ai * 128 + m * 16; float ss = 0.f;
#pragma unroll
                    for (int bj = 0; bj < 2; ++bj) { const f32x4 v0 = acc[ai][bj][m][0] + bv[bj][0], v1 = acc[ai][bj][m][1] + bv[bj][1];
                        ss += ssq8(v0, v1);
                        wsat<u32x4>(ws, (unsigned)WS_QLAT + (unsigned)(row * 256 + bj * 128 + colt) * 2u) = pack8(v0, v1); }
                    ss += __shfl_xor(ss, 16); ss += __shfl_xor(ss, 32);
                    if (fq == 0) wsat<float>(ws, (unsigned)WS_QSS + (unsigned)(row * 4 + wc) * 4u) = ss; }
        } else if (pn == 1) {
#pragma unroll
            for (int ai = 0; ai < 2; ++ai)
#pragma unroll
                for (int m = 0; m < 4; ++m) { const int row = row0 + ai * 128 + m * 16;
                    { const f32x4 v0 = acc[ai][0][m][0] + bv[0][0], v1 = acc[ai][0][m][1] + bv[0][1];
                      float ss = ssq8(v0, v1);
                      wsat<u32x4>(ws, (unsigned)WS_CKV + (unsigned)(row * 128 + colt) * 2u) = pack8(v0, v1);
                      ss += __shfl_xor(ss, 16); ss += __shfl_xor(ss, 32);
                      if (fq == 0) wsat<float>(ws, (unsigned)WS_KSS + (unsigned)(row * 4 + wc) * 4u) = ss; }
                    if (wc == 0) {
                        f32x4 v0 = acc[ai][1][m][0] + bv[1][0], v1 = acc[ai][1][m][1] + bv[1][1];
                        if (u.pm < 256) rope8(v0, v1, row & 4095, fq, ws);
                        const u32x4 w = pack8(v0, v1); const unsigned ko = (unsigned)WS_K + (unsigned)(krow_of(row) * QW + 64 + 8 * fq) * 2u;
#pragma unroll
                        for (int h = 0; h < NH; ++h) wsat<u32x4>(ws, ko + (unsigned)(h * DQK * 2)) = w;
                    } }
        } else {
            const int kind = (pn - 2) >> 1, cbase = ((pn - 2) & 1) * 256 + colt;
            const unsigned dbase = (unsigned)WS_SGM + (unsigned)kind * (unsigned)(WS_FIN - WS_SGM);
#pragma unroll
            for (int ai = 0; ai < 2; ++ai)
#pragma unroll
                for (int m = 0; m < 4; ++m) { const int row = row0 + ai * 128 + m * 16;
#pragma unroll
                    for (int bj = 0; bj < 2; ++bj) { f32x4 v0 = acc[ai][bj][m][0] + bv[bj][0], v1 = acc[ai][bj][m][1] + bv[bj][1];
                        if (kind != 1) { v0 = silu4(v0); v1 = silu4(v1); }
                        wsat<u32x4>(ws, dbase + (unsigned)(row * 512 + cbase + bj * 128) * 2u) = pack8(v0, v1); } }
        }
    }
};
struct EpiQ {
    static constexpr bool PERM = true;
    unsigned char* ws;
    __device__ __forceinline__ void operator()(AccRef acc, const Unit& u, int wr, int wc, int fr, int fq) const {
        const int pn = u.pn, row0 = u.pm * 256 + wr * 64 + fr, colt = wc * 32 + 8 * fq;
#pragma unroll
        for (int ai = 0; ai < 2; ++ai)
#pragma unroll
            for (int m = 0; m < 4; ++m) { const int row = row0 + ai * 128 + m * 16;
                const f32x4 q4 = wsat<f32x4>(ws, (unsigned)WS_QSS + (unsigned)row * 16u);
                const float rs = __builtin_amdgcn_rsqf(((q4[0] + q4[1]) + (q4[2] + q4[3])) * (1.f / 256.f) + LN_EPS) * C2;
#pragma unroll
                for (int bj = 0; bj < 2; ++bj) { f32x4 v0 = acc[ai][bj][m][0] * rs, v1 = acc[ai][bj][m][1] * rs;
                    if (pn < 2) { const int c = pn * 256 + bj * 128 + colt; wsat<u32x4>(ws, (unsigned)WS_Q + (unsigned)(row * QW + (c >> 6) * DQK + (c & 63)) * 2u) = pack8(v0, v1); }
                    else { rope8(v0, v1, row & 4095, fq, ws); wsat<u32x4>(ws, (unsigned)WS_Q + (unsigned)(row * QW + (4 * bj + wc) * DQK + 64 + 8 * fq) * 2u) = pack8(v0, v1); } } }
    }
};
struct EpiKV {
    static constexpr bool PERM = true;
    unsigned char* ws;
    __device__ __forceinline__ void operator()(AccRef acc, const Unit& u, int wr, int wc, int fr, int fq) const {
        const int pn = u.pn, row0 = u.pm * 256 + wr * 64 + fr, colt = wc * 32 + 8 * fq;
#pragma unroll
        for (int ai = 0; ai < 2; ++ai)
#pragma unroll
            for (int m = 0; m < 4; ++m) { const int row = row0 + ai * 128 + m * 16; const int kr = krow_of(row);
                const f32x4 q4 = wsat<f32x4>(ws, (unsigned)WS_KSS + (unsigned)row * 16u);
                const float rs = __builtin_amdgcn_rsqf(((q4[0] + q4[1]) + (q4[2] + q4[3])) * (1.f / 128.f) + LN_EPS);
#pragma unroll
                for (int bj = 0; bj < 2; ++bj) { const f32x4 v0 = acc[ai][bj][m][0] * rs, v1 = acc[ai][bj][m][1] * rs;
                    if (pn < 2) { const int c = pn * 256 + bj * 128 + colt; wsat<u32x4>(ws, (unsigned)WS_K + (unsigned)(kr * QW + (c >> 6) * DQK + (c & 63)) * 2u) = pack8(v0, v1); }
                    else { const int c = (pn - 2) * 256 + bj * 128 + colt; wsat<u32x4>(ws, (unsigned)WS_V + (unsigned)(kr * VW + c) * 2u) = pack8(v0, v1); } } }
    }
};
struct EpiF0 {
    static constexpr bool PERM = true;
    unsigned char* ws;
    __device__ __forceinline__ void operator()(AccRef acc, const Unit& u, int wr, int wc, int fr, int fq) const {
        const int bg = u.pn >> 4, bgrp = u.pn & 15;
        const unsigned base = (unsigned)WS_X + ((unsigned)((bg * 128 + wr * 64 + fr) * 64 + 4 * bgrp + (wc >> 1)) * 128u + 32u * (wc & 1) + 8u * fq) * 2u;
#pragma unroll
        for (int ai = 0; ai < 2; ++ai)
#pragma unroll
            for (int m = 0; m < 4; ++m)
#pragma unroll
                for (int bj = 0; bj < 2; ++bj)
                    wsat<u32x4>(ws, base + (unsigned)(((m * 16 * 64 + 2 * bj) * 128 + ai * 64) * 2)) = pack8(acc[ai][bj][m][0], acc[ai][bj][m][1]);
    }
};
struct EpiF1 {
    static constexpr bool PERM = true;
    unsigned char* ws;
    __device__ __forceinline__ void operator()(AccRef acc, const Unit& u, int wr, int wc, int fr, int fq) const {
        if (wr != 0) return;
        const int bg = u.pn >> 5, mq = u.pn & 31;
        const int b0 = 32 * (wc & 1) + 8 * fq;
        const unsigned base = (unsigned)WS_Y2 + ((unsigned)(((bg * 64 + fr) * 128 + 4 * mq + (wc >> 1)) * 2) * 64u + (unsigned)b0) * 2u;
        unsigned tbase = (unsigned)(fr * 64 + b0) * 4u; asm volatile("" : "+v"(tbase));
#pragma unroll
        for (int m = 0; m < 4; ++m)
#pragma unroll
            for (int n = 0; n < 2; ++n) {
                const unsigned to = tbase + (unsigned)((m * 16 * 64 + 4 * n) * 4);
                const f32x4 c = wsat<f32x4>(ws, (unsigned)WS_TWC + to), sn = wsat<f32x4>(ws, (unsigned)WS_TWS + to);
#pragma unroll
                for (int bj = 0; bj < 2; ++bj) {
                    const f32x4 re = acc[0][bj][m][n], im = acc[1][bj][m][n]; const f32x4 orr = re * c + im * sn, oi = im * c - re * sn;
                    const unsigned off = base + (unsigned)(((m * 16 * 128 + 2 * bj) * 2 * 64 + 4 * n) * 2);
                    uint2 w0, w1; w0.x = cvtpk(orr[0], orr[1]); w0.y = cvtpk(orr[2], orr[3]); w1.x = cvtpk(oi[0], oi[1]); w1.y = cvtpk(oi[2], oi[3]);
                    wsat<uint2>(ws, off) = w0; wsat<uint2>(ws, off + 128u) = w1; }
                asm volatile("" ::: "memory");
            }
    }
};
struct EpiF2 {
    static constexpr bool PERM = true;
    unsigned char* ws;
    __device__ __forceinline__ void operator()(AccRef acc, const Unit& u, int wr, int wc, int fr, int fq) const {
        if (wr != 0) return;
        const int bg = u.pn >> 5, dq = u.pn & 31, batch = bg >> 2, g = bg & 3;
#pragma unroll
        for (int m = 0; m < 4; ++m) { const int c = m * 16 + fr;
#pragma unroll
            for (int bj = 0; bj < 2; ++bj) { const int d = 2 * dq + bj, mcol0 = 32 * wc + 8 * fq;
                wsat<u32x4>(ws, (unsigned)WS_Z + (unsigned)((batch * 4096 + 64 * c + d) * 512 + 128 * g + mcol0) * 2u) = pack8(acc[0][bj][m][0], acc[0][bj][m][1]); } }
    }
};
struct EpiF3 {
    static constexpr bool PERM = true;
    unsigned char* ws; const float* bias;
    __device__ __forceinline__ void operator()(AccRef acc, const Unit& u, int wr, int wc, int fr, int fq) const {
        const int row0 = u.pm * 256 + wr * 64 + fr, col0 = u.pn * 256 + wc * 32 + 8 * fq;
        f32x4 bv[2][2];
#pragma unroll
        for (int bj = 0; bj < 2; ++bj)
#pragma unroll
            for (int n = 0; n < 2; ++n) bv[bj][n] = *(const f32x4*)(bias + col0 + bj * 128 + 4 * n);
#pragma unroll
        for (int ai = 0; ai < 2; ++ai)
#pragma unroll
            for (int m = 0; m < 4; ++m) { const int row = row0 + ai * 128 + m * 16;
#pragma unroll
                for (int bj = 0; bj < 2; ++bj) { const int c = col0 + bj * 128; const u32x4 gq = wsat<u32x4>(ws, (unsigned)WS_SGF + (unsigned)(row * 512 + c) * 2u);
                    f32x4 v0 = acc[ai][bj][m][0] + bv[bj][0], v1 = acc[ai][bj][m][1] + bv[bj][1];
                    v0 = v0 * (f32x4){bf_lo(gq.x), bf_hi(gq.x), bf_lo(gq.y), bf_hi(gq.y)}; v1 = v1 * (f32x4){bf_lo(gq.z), bf_hi(gq.z), bf_lo(gq.w), bf_hi(gq.w)};
                    wsat<u32x4>(ws, (unsigned)WS_YMIX + (unsigned)(row * 1024 + 512 + c) * 2u) = pack8(v0, v1); } }
    }
};
struct EpiOut {
    static constexpr bool PERM = false;
    unsigned char* ws; const float* bias; const float* x; float* R;
    __device__ __forceinline__ void operator()(AccRef acc, const Unit& u, int wr, int wc, int fr, int fq) const {
        const int row0 = u.pm * 256 + wr * 64 + fr, col0 = u.pn * 256 + wc * 32 + 4 * fq;
        const unsigned gate = (unsigned)WS_MOD + (unsigned)((u.pm >> 4) * 3072 + 2048 + col0) * 4u;
        f32x4 bv[2][2], gv[2][2];
#pragma unroll
        for (int bj = 0; bj < 2; ++bj)
#pragma unroll
            for (int n = 0; n < 2; ++n) { bv[bj][n] = *(const f32x4*)(bias + col0 + bj * 128 + 16 * n); gv[bj][n] = wsat<f32x4>(ws, gate + (unsigned)(bj * 128 + 16 * n) * 4u); }
#pragma unroll
        for (int ai = 0; ai < 2; ++ai)
#pragma unroll
            for (int m = 0; m < 4; ++m) { const unsigned off = (unsigned)((row0 + ai * 128 + m * 16) * 1024 + col0) * 4u;
#pragma unroll
                for (int bj = 0; bj < 2; ++bj)
#pragma unroll
                    for (int n = 0; n < 2; ++n) { const unsigned o2 = off + (unsigned)(bj * 128 + 16 * n) * 4u; const f32x4 xv = *(const f32x4*)((const unsigned char*)x + (size_t)o2);
                        *(f32x4*)((unsigned char*)R + (size_t)o2) = xv * ALPHA + gv[bj][n] * (acc[ai][bj][m][n] + bv[bj][n]); } }
    }
};

namespace att {
constexpr int NSLOT = 3, KSLOTB = 12288, VSLOTB = 8192;
constexpr int LDS_K = 0, LDS_V = NSLOT * KSLOTB, LDS_Q = LDS_V + NSLOT * VSLOTB, LDS_WS = LDS_Q + 8 * 6144, LDS_TOTAL = LDS_WS + 8 * 256;
static_assert(LDS_TOTAL <= 131072, "attention LDS");
constexpr int NT = SKV / 64;
typedef LAS const char* lds_cptr;
typedef short v4i16_t __attribute__((ext_vector_type(4)));
#define SBAR() __builtin_amdgcn_sched_barrier(0)
#define WAIT_BAR(N) asm volatile("s_waitcnt vmcnt(" #N ") lgkmcnt(0)\n\ts_barrier" ::: "memory")
__device__ __forceinline__ int crow(int r, int hi) { return (r & 3) + 8 * (r >> 2) + 4 * hi; }
__device__ __forceinline__ void glds16(const void* gsrc, unsigned lds_dst) { unsigned keep;
    asm volatile("s_mov_b32 %0, m0\n\ts_mov_b32 m0, %2\n\ts_nop 0\n\tglobal_load_lds_dwordx4 %1, off\n\ts_mov_b32 m0, %0" : "=&s"(keep) : "v"(gsrc), "s"(lds_dst) : "memory"); }
__device__ __forceinline__ float max3f(float a, float b, float c) { float r; asm("v_max3_f32 %0, %1, %2, %3" : "=v"(r) : "v"(a), "v"(b), "v"(c)); return r; }
__device__ __forceinline__ float max2f(float a, float b) { float r; asm("v_max_f32_e32 %0, %1, %2" : "=v"(r) : "v"(a), "v"(b)); return r; }
__device__ __forceinline__ float fadd_s(float a, float b) { float r; asm("v_add_f32_e32 %0, %1, %2" : "=v"(r) : "v"(a), "v"(b)); return r; }
__device__ __forceinline__ float fsub_s(float a, float b) { float r; asm("v_sub_f32_e32 %0, %1, %2" : "=v"(r) : "v"(a), "v"(b)); return r; }
__device__ __forceinline__ void kload2(bf16x8* kf, lds_cptr kp, int j) { kf[2 * j] = *(const LAS bf16x8*)(kp + j * 2048); kf[2 * j + 1] = *(const LAS bf16x8*)(kp + j * 2048 + 512); }
__device__ __forceinline__ s16x4 vtr(lds_cptr p) { return __builtin_bit_cast(s16x4, __builtin_amdgcn_ds_read_tr16_b64_v4i16((LAS v4i16_t*)p)); }
__device__ __forceinline__ float rowmax(const f32x16& p0, const f32x16& p1) {
    float a = max3f(p0[0], p0[1], p1[0]), b = max3f(p0[2], p0[3], p1[1]); a = max3f(a, p1[2], p1[3]);
#pragma unroll
    for (int r = 4; r < 16; r += 4) { a = max3f(a, p0[r], p0[r + 1]); b = max3f(b, p0[r + 2], p0[r + 3]); a = max3f(a, p1[r], p1[r + 1]); b = max3f(b, p1[r + 2], p1[r + 3]); }
    const float m = max2f(a, b);
    auto rr = __builtin_amdgcn_permlane32_swap(__float_as_uint(m), __float_as_uint(m), false, false);
    return max2f(__uint_as_float(rr[0]), __uint_as_float(rr[1]));
}
__device__ __forceinline__ void pv(f32x16* o, int vb, bf16x8 pa0, bf16x8 pa1, bf16x8 pa2, bf16x8 pa3) {
#pragma unroll
    for (int d0 = 0; d0 < 2; ++d0) { s16x4 lo[4], hi[4];
#pragma unroll
        for (int ks = 0; ks < 4; ++ks) {
            asm volatile("ds_read_b64_tr_b16 %0,%1 offset:%c2" : "=&v"(lo[ks]) : "v"(vb), "i"(d0 * 4096 + ks * 1024) : "memory");
            asm volatile("ds_read_b64_tr_b16 %0,%1 offset:%c2" : "=&v"(hi[ks]) : "v"(vb), "i"(d0 * 4096 + ks * 1024 + 512) : "memory"); }
        asm volatile("s_waitcnt lgkmcnt(0)" ::: "memory"); SBAR();
#define PK(k) (bf16x8){lo[k][0], lo[k][1], lo[k][2], lo[k][3], hi[k][0], hi[k][1], hi[k][2], hi[k][3]}
        o[d0] = __builtin_amdgcn_mfma_f32_32x32x16_bf16(pa0, PK(0), o[d0], 0, 0, 0);
        o[d0] = __builtin_amdgcn_mfma_f32_32x32x16_bf16(pa1, PK(1), o[d0], 0, 0, 0);
        o[d0] = __builtin_amdgcn_mfma_f32_32x32x16_bf16(pa2, PK(2), o[d0], 0, 0, 0);
        o[d0] = __builtin_amdgcn_mfma_f32_32x32x16_bf16(pa3, PK(3), o[d0], 0, 0, 0);
#undef PK
    }
}
template <int THRL>
__device__ __forceinline__ void attn_unit(int b, int h, int qb, const bf16_t* Q, const bf16_t* __restrict__ K, const bf16_t* __restrict__ V, const bf16_t* SGM, bf16_t* YMIX, LAS unsigned char* lds) {
    int tid_ = threadIdx.x; asm volatile("" : "+v"(tid_));
    const int tid = tid_, lane = tid & 63, r32 = lane & 31, hi = lane >> 5; const int wid = __builtin_amdgcn_readfirstlane(tid >> 6);
    const size_t krow0 = (size_t)b * SKV; const int qrow0 = b * SEQ + qb * 256 + wid * 32;
    const bf16_t* Kh = K + krow0 * QW + h * DQK; const bf16_t* Vh = V + krow0 * VW + h * DV;
    const unsigned lds0 = (unsigned)(uintptr_t)lds;
    LAS float* wsf = (LAS float*)(lds + LDS_WS) + wid * 64;
    const bf16_t* ksrc0 = Kh + (size_t)lane * QW + wid * 8;
    const bf16_t* ksrc1 = Kh + (size_t)lane * QW + (8 + (wid & 3)) * 8;
    const bf16_t* vsrc = Vh + (size_t)(16 * (wid & 3) + (lane >> 2)) * VW + (wid >> 2) * 32 + (lane & 3) * 8;
    const unsigned kdst0 = lds0 + LDS_K + wid * 1024, kdst1 = lds0 + LDS_K + (8 + (wid & 3)) * 1024, vdst = lds0 + LDS_V + wid * 1024;
#define DMA_K(t, slot) do { glds16(ksrc0 + (size_t)(t) * 64 * QW, (unsigned)__builtin_amdgcn_readfirstlane(kdst0 + (slot))); glds16(ksrc1 + (size_t)(t) * 64 * QW, (unsigned)__builtin_amdgcn_readfirstlane(kdst1 + (slot))); } while (0)
#define DMA_V(t, slot) glds16(vsrc + (size_t)(t) * 64 * VW, (unsigned)__builtin_amdgcn_readfirstlane(vdst + (slot)))
    const lds_cptr shm3 = (lds_cptr)lds; const lds_cptr kp0 = shm3 + LDS_K + hi * 1024 + r32 * 16;
    const lds_cptr vp0 = shm3 + LDS_V + ((lane >> 4) & 1) * 32 + (lane & 3) * 8 + (4 * hi + ((lane & 15) >> 2)) * 64;
    const int vb0 = (int)(lds0 + LDS_V) + ((lane >> 4) & 1) * 32 + (lane & 3) * 8 + (4 * hi + ((lane & 15) >> 2)) * 64;
    LAS char* qb_ = (LAS char*)lds + LDS_Q + wid * 6144 + hi * 512 + r32 * 16;
    DMA_K(0, 0); DMA_V(0, 0); DMA_K(1, KSLOTB);
    {
        bf16x8 qt[6];
#pragma unroll
        for (int d0 = 0; d0 < 6; ++d0) qt[d0] = *(const bf16x8*)(Q + (size_t)(qrow0 + r32) * QW + h * DQK + d0 * 16 + hi * 8);
#pragma unroll
        for (int d0 = 0; d0 < 6; ++d0) *(LAS bf16x8*)(qb_ + d0 * 1024) = qt[d0];
    }
    bf16x8 kf[12], qA, qB;
    float mhat = 0.f, l_reg = 0.f; f32x16 o[2]; o[0] = f32x16{}; o[1] = f32x16{}; f32x16 negm = f32x16{}; asm volatile("" : "+v"(negm));
    bool resc = false;
#define START(P0, P1) do { const float rm = rowmax(P0, P1); resc = false; \
    { const float dl = rm; mhat = fadd_s(mhat, dl); \
      _Pragma("unroll") for (int r = 0; r < 16; ++r) { P0[r] = fsub_s(P0[r], dl); P1[r] = fsub_s(P1[r], dl); } \
      _Pragma("unroll") for (int r = 0; r < 16; ++r) negm[r] = -mhat; asm volatile("" : "+v"(negm)); } \
    _Pragma("unroll") for (int r = 0; r < 16; ++r) P0[r] = __builtin_amdgcn_exp2f(P0[r]); } while (0)
#define RESC() do { if (resc) { asm volatile("s_waitcnt lgkmcnt(0)" ::: "memory"); \
      _Pragma("unroll") for (int d_ = 0; d_ < 2; ++d_) _Pragma("unroll") for (int r = 0; r < 16; ++r) o[d_][r] *= wsf[crow(r, hi)]; } } while (0)
    f32x16 pA0, pA1, pB0, pB1;
    int sk_prev = 0, sk_cur = 0, sk_next = KSLOTB, sv_prev = 0, sv_cur = 0, sv_next = VSLOTB;
#define ROT() do { sk_prev = sk_cur; sk_cur = sk_next; sk_next = (sk_next == (NSLOT - 1) * KSLOTB) ? 0 : sk_next + KSLOTB; sv_prev = sv_cur; sv_cur = sv_next; sv_next = (sv_next == (NSLOT - 1) * VSLOTB) ? 0 : sv_next + VSLOTB; } while (0)
    DMA_K(2, 2 * KSLOTB);
    WAIT_BAR(5);
    { bf16x8 q6[6];
#pragma unroll
      for (int d0 = 0; d0 < 6; ++d0) q6[d0] = *(const LAS bf16x8*)(qb_ + d0 * 1024);
#pragma unroll
      for (int d0 = 0; d0 < 6; ++d0) { const bf16x8 b0 = *(const LAS bf16x8*)(kp0 + d0 * 2048), b1 = *(const LAS bf16x8*)(kp0 + d0 * 2048 + 512);
          if (d0 == 0) { pA0 = __builtin_amdgcn_mfma_f32_32x32x16_bf16(b0, q6[0], negm, 0, 0, 0); pA1 = __builtin_amdgcn_mfma_f32_32x32x16_bf16(b1, q6[0], negm, 0, 0, 0); }
          else { pA0 = __builtin_amdgcn_mfma_f32_32x32x16_bf16(b0, q6[d0], pA0, 0, 0, 0); pA1 = __builtin_amdgcn_mfma_f32_32x32x16_bf16(b1, q6[d0], pA1, 0, 0, 0); } }
      qA = q6[0]; }
    asm volatile("s_nop 15\n\ts_nop 7" : "+v"(pA0), "+v"(pA1));
    START(pA0, pA1);
#pragma unroll
    for (int r = 0; r < 16; ++r) pA1[r] = __builtin_amdgcn_exp2f(pA1[r]);
    WAIT_BAR(0);
    DMA_K(3, 0); DMA_V(1, VSLOTB);
    ROT();
#pragma unroll
    for (int j = 0; j < 6; ++j) kload2(kf, kp0 + sk_cur, j);
    WAIT_BAR(3);
    s16x4 vlo[8], vhi[8]; u32x4 pw0, pw1, pw2, pw3;
#define PKW(P, B) cvtpk(P[B], P[B + 1])
#define PAF(k) __builtin_bit_cast(bf16x8, pw##k)
#define VFR(i) (bf16x8){vlo[i][0], vlo[i][1], vlo[i][2], vlo[i][3], vhi[i][0], vhi[i][1], vhi[i][2], vhi[i][3]}
#define PIN(x) asm volatile("" : "+v"(x))
#define MX3(a, b, c) __builtin_fmaxf(__builtin_fmaxf((a), (b)), (c))
#define MFMA(a, b, c) __builtin_amdgcn_mfma_f32_32x32x16_bf16(a, b, c, 0, 0, 0)
#define GAPA(MF, A0, A1, A2, W0, W1, PW) do { MF; sacc += A0; sacc += A1; sacc += A2; PIN(sacc); W0; W1; PIN(PW); SBAR(); } while (0)
#define GAPAn(MF, A0, A1, A2) do { MF; sacc += A0; sacc += A1; sacc += A2; PIN(sacc); SBAR(); } while (0)
#define GAPA0(MF) do { MF; SBAR(); } while (0)
#define EX(v) __builtin_amdgcn_exp2f(v)
#define GAPB(MF, X, B) do { MF; X[B] = EX(X[B]); X[B + 1] = EX(X[B + 1]); X[B + 2] = EX(X[B + 2]); X[B + 3] = EX(X[B + 3]); PIN(X); SBAR(); } while (0)
#define VRD(i) do { vlo[i] = vtr(vp_ + (((i) >> 2) * 4096 + ((i) & 3) * 1024)); vhi[i] = vtr(vp_ + (((i) >> 2) * 4096 + ((i) & 3) * 1024 + 512)); } while (0)
#define QRD(dst, d0) dst = *(const LAS bf16x8*)(qb_ + (d0) * 1024)
#define KRD(G, j) do { if (G) { kload2(kf, kp0 + sk_next, j); SBAR(); } } while (0)
#define STEP(C0, C1, P0, P1, t, GK, GV, GL) do { SBAR(); \
    const lds_cptr vp_ = vp0 + sv_prev; \
    VRD(0); QRD(qB, 1); SBAR(); float sacc = (P0[0] + P0[1]); \
    GAPA(C0 = MFMA(kf[0], qA, negm), P0[2], P0[3], P0[4],     pw0[0] = PKW(P0, 0),  pw0[1] = PKW(P0, 2),  pw0); \
    VRD(4); SBAR();             GAPA(C1 = MFMA(kf[1], qA, negm), P0[5], P0[6], P0[7],     pw0[2] = PKW(P0, 4),  pw0[3] = PKW(P0, 6),  pw0); \
    VRD(1); QRD(qA, 2); SBAR(); GAPA(C0 = MFMA(kf[2], qB, C0),   P0[8], P0[9], P0[10],    pw1[0] = PKW(P0, 8),  pw1[1] = PKW(P0, 10), pw1); \
    VRD(5); SBAR();             GAPA(C1 = MFMA(kf[3], qB, C1),   P0[11], P0[12], P0[13],  pw1[2] = PKW(P0, 12), pw1[3] = PKW(P0, 14), pw1); \
    VRD(2); QRD(qB, 3); SBAR(); GAPA(C0 = MFMA(kf[4], qA, C0),   P0[14], P0[15], P1[0],   pw2[0] = PKW(P1, 0),  pw2[1] = PKW(P1, 2),  pw2); \
    VRD(6); SBAR();             GAPA(C1 = MFMA(kf[5], qA, C1),   P1[1], P1[2], P1[3],     pw2[2] = PKW(P1, 4),  pw2[3] = PKW(P1, 6),  pw2); \
    VRD(3); QRD(qA, 4); SBAR(); GAPA(C0 = MFMA(kf[6], qB, C0),   P1[4], P1[5], P1[6],     pw3[0] = PKW(P1, 8),  pw3[1] = PKW(P1, 10), pw3); \
    VRD(7); SBAR();             GAPA(C1 = MFMA(kf[7], qB, C1),   P1[7], P1[8], P1[9],     pw3[2] = PKW(P1, 12), pw3[3] = PKW(P1, 14), pw3); \
    QRD(qB, 5); SBAR();         GAPAn(C0 = MFMA(kf[8], qA, C0),  P1[10], P1[11], P1[12]); \
                                GAPAn(C1 = MFMA(kf[9], qA, C1),  P1[13], P1[14], P1[15]); \
    QRD(qA, 0); SBAR();         GAPA0(C0 = MFMA(kf[10], qB, C0)); \
                                GAPA0(C1 = MFMA(kf[11], qB, C1)); \
    l_reg += sacc; \
    if (GK) { DMA_K((t) + 3, sk_cur); } if (GV) { DMA_V((t) + 1, sv_next); } \
    { float a = MX3(C0[0], C0[1], C1[0]), b_ = MX3(C0[2], C0[3], C1[1]); a = MX3(a, C1[2], C1[3]); \
      _Pragma("unroll") for (int r = 4; r < 16; r += 4) { a = MX3(a, C0[r], C0[r + 1]); b_ = MX3(b_, C0[r + 2], C0[r + 3]); a = MX3(a, C1[r], C1[r + 1]); b_ = MX3(b_, C1[r + 2], C1[r + 3]); } \
      float rm = __builtin_fmaxf(a, b_); { auto rr = __builtin_amdgcn_permlane32_swap(__float_as_uint(rm), __float_as_uint(rm), false, false); rm = __builtin_fmaxf(__uint_as_float(rr[0]), __uint_as_float(rr[1])); } \
      resc = false; \
      if (__builtin_expect(__any(rm > (float)THRL), 0)) { const float dl = __builtin_fmaxf(rm, 0.f); mhat += dl; \
        _Pragma("unroll") for (int r = 0; r < 16; ++r) { C0[r] -= dl; C1[r] -= dl; } \
        _Pragma("unroll") for (int r = 0; r < 16; ++r) negm[r] = -mhat; asm volatile("" : "+v"(negm)); \
        const float f = __builtin_amdgcn_exp2f(-dl); l_reg *= f; if (hi == 0) wsf[r32] = f; resc = true; } } \
    SBAR(); \
                GAPB(o[0] = MFMA(PAF(0), VFR(0), o[0]), C0, 0); \
    KRD(GL, 0); GAPB(o[1] = MFMA(PAF(0), VFR(4), o[1]), C0, 4); \
    KRD(GL, 1); GAPB(o[0] = MFMA(PAF(1), VFR(1), o[0]), C0, 8); \
    KRD(GL, 2); GAPB(o[1] = MFMA(PAF(1), VFR(5), o[1]), C0, 12); \
    KRD(GL, 3); GAPB(o[0] = MFMA(PAF(2), VFR(2), o[0]), C1, 0); \
    KRD(GL, 4); GAPB(o[1] = MFMA(PAF(2), VFR(6), o[1]), C1, 4); \
    KRD(GL, 5); GAPB(o[0] = MFMA(PAF(3), VFR(3), o[0]), C1, 8); \
                GAPB(o[1] = MFMA(PAF(3), VFR(7), o[1]), C1, 12); \
    } while (0)
    int t = 1;
    for (; t + 5 < NT; t += 2) {
        STEP(pB0, pB1, pA0, pA1, t, true, true, true);     WAIT_BAR(3); RESC(); ROT();
        STEP(pA0, pA1, pB0, pB1, t + 1, true, true, true); WAIT_BAR(3); RESC(); ROT();
    }
#define ENDW(tt) do { if ((tt) + 3 < NT) { WAIT_BAR(3); } else if ((tt) + 2 < NT) { WAIT_BAR(1); } else { WAIT_BAR(0); } } while (0)
    for (; t + 1 < NT; t += 2) {
        STEP(pB0, pB1, pA0, pA1, t, (t + 3 < NT), (t + 1 < NT), (t + 1 < NT));         ENDW(t);     RESC(); ROT();
        STEP(pA0, pA1, pB0, pB1, t + 1, (t + 4 < NT), (t + 2 < NT), (t + 2 < NT));     ENDW(t + 1); RESC(); ROT();
    }
    STEP(pB0, pB1, pA0, pA1, NT - 1, false, false, false); RESC();
    { float sacc = pB0[0] + pB0[1];
#pragma unroll
      for (int r = 2; r < 16; ++r) sacc += pB0[r];
#pragma unroll
      for (int r = 0; r < 16; ++r) sacc += pB1[r];
      l_reg += sacc;
      pw0 = (u32x4){PKW(pB0, 0), PKW(pB0, 2), PKW(pB0, 4), PKW(pB0, 6)}; pw1 = (u32x4){PKW(pB0, 8), PKW(pB0, 10), PKW(pB0, 12), PKW(pB0, 14)};
      pw2 = (u32x4){PKW(pB1, 0), PKW(pB1, 2), PKW(pB1, 4), PKW(pB1, 6)}; pw3 = (u32x4){PKW(pB1, 8), PKW(pB1, 10), PKW(pB1, 12), PKW(pB1, 14)};
      SBAR(); pv(o, vb0 + sv_cur, PAF(0), PAF(1), PAF(2), PAF(3)); }
#undef PKW
#undef PAF
#undef VFR
#undef PIN
#undef MX3
#undef MFMA
#undef GAPA
#undef GAPAn
#undef GAPA0
#undef GAPB
#undef EX
#undef VRD
#undef QRD
#undef KRD
#undef STEP
#undef ENDW
    { auto rr = __builtin_amdgcn_permlane32_swap(__float_as_uint(l_reg), __float_as_uint(l_reg), false, false); l_reg = __uint_as_float(rr[0]) + __uint_as_float(rr[1]); }
    if (hi == 0) wsf[32 + r32] = l_reg; asm volatile("s_waitcnt lgkmcnt(0)" ::: "memory");
    float rli[16];
#pragma unroll
    for (int r = 0; r < 16; ++r) rli[r] = __builtin_amdgcn_rcpf(wsf[32 + crow(r, hi)]);
    { LAS bf16_t* stg = (LAS bf16_t*)(lds + LDS_Q + wid * 6144);
#pragma unroll
      for (int r = 0; r < 16; ++r) { const int orow = crow(r, hi);
#pragma unroll
          for (int d0 = 0; d0 < 2; ++d0) stg[orow * 64 + d0 * 32 + r32] = (bf16_t)(cvtpk(o[d0][r] * rli[r], 0.f) & 0xffffu); }
      asm volatile("s_waitcnt lgkmcnt(0)" ::: "memory");
#pragma unroll
      for (int i = 0; i < 4; ++i) { const int row = i * 8 + (lane >> 3), ch = lane & 7; const u32x4 v = *(const LAS u32x4*)(stg + row * 64 + ch * 8);
          const size_t grow = (size_t)(qrow0 + row);
          const u32x4 g = *(const u32x4*)(SGM + grow * 512 + h * DV + ch * 8);
          u32x4 w; w.x = cvtpk(bf_lo(v.x) * bf_lo(g.x), bf_hi(v.x) * bf_hi(g.x)); w.y = cvtpk(bf_lo(v.y) * bf_lo(g.y), bf_hi(v.y) * bf_hi(g.y));
          w.z = cvtpk(bf_lo(v.z) * bf_lo(g.z), bf_hi(v.z) * bf_hi(g.z)); w.w = cvtpk(bf_lo(v.w) * bf_lo(g.w), bf_hi(v.w) * bf_hi(g.w));
          *(u32x4*)(YMIX + grow * 1024 + h * DV + ch * 8) = w; } }
    asm volatile("s_waitcnt vmcnt(0) lgkmcnt(0)\n\ts_barrier" ::: "memory");
#undef DMA_K
#undef DMA_V
#undef START
#undef RESC
#undef ROT
}
#undef SBAR
#undef WAIT_BAR
}

__device__ __forceinline__ float cos_rev(double rev) { rev -= floor(rev); return __builtin_amdgcn_cosf((float)rev); }
__device__ __forceinline__ float sin_rev(double rev) { rev -= floor(rev); return __builtin_amdgcn_sinf((float)rev); }
__device__ __forceinline__ void transpose_item(const float* W, int K, int N, bf16_t* WT, int k0, int n0, int drow0, const float* kscale, LAS float* scr, int lane) {
#pragma unroll 8
    for (int i = 0; i < 32; ++i) { const int kk = 2 * i + (lane >> 5); float v = W[(size_t)(k0 + kk) * N + n0 + (lane & 31)]; if (kscale) v *= kscale[k0 + kk]; scr[kk * 33 + (lane & 31)] = v; }
    asm volatile("s_waitcnt lgkmcnt(0)" ::: "memory");
    const int c = lane & 7;
#pragma unroll
    for (int j = 0; j < 4; ++j) { const int n = (lane >> 3) + 8 * j; const LAS float* s = scr + (8 * c) * 33 + n;
        u32x4 o; o.x = cvtpk(s[0 * 33], s[1 * 33]); o.y = cvtpk(s[2 * 33], s[3 * 33]); o.z = cvtpk(s[4 * 33], s[5 * 33]); o.w = cvtpk(s[6 * 33], s[7 * 33]);
        *(u32x4*)(WT + (size_t)(drow0 + n) * K + k0 + 8 * c) = o; }
    asm volatile("s_waitcnt lgkmcnt(0)" ::: "memory");
}
__device__ __forceinline__ int win_drow(int j) {
    if (j < 416) return j;
    if (j < 928) return 512 + (j - 416);
    if (j < 1440) return 1024 + (j - 928);
    return 1536 + (j - 1440);
}


#define XB_TMO      128
#define XB_XCNT(j)  (256  + 64 * (j))
#define XB_XSUB(j)  (1280 + 64 * (j))
#define XB_XGEN(j)  (2304 + 64 * (j))
#define XB_TOP      3328
#define XB_TOPGEN   3392
#define XCD_BAR_WORDS 3456
#define XB_SPIN_CAP (1u << 18)
__device__ __forceinline__ unsigned xb_ld(unsigned* p)              { return __hip_atomic_load(p, __ATOMIC_RELAXED, __HIP_MEMORY_SCOPE_AGENT); }
__device__ __forceinline__ unsigned xb_add(unsigned* p, unsigned v) { return __hip_atomic_fetch_add(p, v, __ATOMIC_RELAXED, __HIP_MEMORY_SCOPE_AGENT); }
__device__ __forceinline__ unsigned xb_xcc_id() { return (unsigned)__builtin_amdgcn_s_getreg((3 << 11) | 20) & 0xFu; }
#define XB_SPIN(cond, bar) do { unsigned _sp = 0; while (cond) { __builtin_amdgcn_s_sleep(1); \
    if ((++_sp & 255u) == 0u) { if (xb_ld(&(bar)[XB_TMO])) break; if (_sp > XB_SPIN_CAP) { atomicAdd(&(bar)[XB_TMO], 1u); break; } } } } while (0)
struct XcdBarrier { unsigned* bar; unsigned x; volatile LAS unsigned* st; };
__device__ __forceinline__ XcdBarrier xcd_barrier_post(unsigned* bar, volatile LAS unsigned* st) {
    XcdBarrier b; b.bar = bar; b.x = xb_xcc_id(); b.st = st;
    if (threadIdx.x == 0) (void)xb_add(&bar[XB_XCNT(b.x)], 1u);
    return b;
}
__device__ __forceinline__ void xcd_barrier_complete(unsigned* bar, unsigned x, unsigned& nloc, unsigned& nx) {
    const unsigned G = gridDim.x * gridDim.y * gridDim.z;
    unsigned sum, cnt, mine, sp = 0u;
    for (;;) {
        sum = 0u; cnt = 0u; mine = 0u;
#pragma unroll
        for (unsigned j = 0; j < 16; ++j) { const unsigned c = xb_ld(&bar[XB_XCNT(j)]); sum += c; cnt += (c > 0u) ? 1u : 0u; mine = (j == x) ? c : mine; }
        if (sum == G) break;
        __builtin_amdgcn_s_sleep(1);
        if ((++sp & 255u) == 0u) { if (xb_ld(&bar[XB_TMO])) break; if (sp > XB_SPIN_CAP) { atomicAdd(&bar[XB_TMO], 1u); break; } }
    }
    nloc = mine > 0u ? mine : 1u; nx = cnt > 0u ? cnt : 1u;
}
__device__ __forceinline__ void xcd_barrier(const XcdBarrier& b) {
    asm volatile("s_waitcnt vmcnt(0)" ::: "memory");
    __syncthreads();
    if (threadIdx.x == 0) {
        unsigned* bar = b.bar;
        __builtin_amdgcn_s_waitcnt(0);
        unsigned nloc = b.st[0], nx = b.st[1];
        if (nloc == 0u) { xcd_barrier_complete(bar, b.x, nloc, nx); b.st[0] = nloc; b.st[1] = nx; }
        const unsigned old = xb_add(&bar[XB_XSUB(b.x)], 1u);
        const unsigned gen = old / nloc;
        if (old + 1u == (gen + 1u) * nloc) {
            __builtin_amdgcn_fence(__ATOMIC_RELEASE, "agent");
            asm volatile("s_waitcnt vmcnt(0)" ::: "memory");
            const unsigned og = xb_add(&bar[XB_TOP], 1u);
            const unsigned tg = og / nx;
            if (og + 1u == (tg + 1u) * nx) xb_add(&bar[XB_TOPGEN], 1u);
            else XB_SPIN(xb_ld(&bar[XB_TOPGEN]) == tg, bar);
            __builtin_amdgcn_fence(__ATOMIC_ACQUIRE, "agent");
            xb_add(&bar[XB_XGEN(b.x)], 1u);
            asm volatile("s_waitcnt vmcnt(0)" ::: "memory");
        } else {
            XB_SPIN(xb_ld(&bar[XB_XGEN(b.x)]) == gen, bar);
            __builtin_amdgcn_fence(__ATOMIC_ACQUIRE, "agent");
            asm volatile("s_waitcnt vmcnt(0)" ::: "memory");
        }
    }
    __syncthreads();
}

#ifndef PH_MASK
#define PH_MASK 0xFFFF
#endif
#define PH(k) ((PH_MASK >> (k)) & 1)
struct Args { const float* in[18]; float* out; unsigned char* ws; };

__global__ void __launch_bounds__(NTHR, 2) mk_fwd(Args a) {
    extern __shared__ __attribute__((aligned(16))) unsigned char lds_raw[];
    LAS unsigned char* lds = (LAS unsigned char*)lds_raw;
    cg::grid_group grid = cg::this_grid();
    const int tid = threadIdx.x, lane = tid & 63, wave = __builtin_amdgcn_readfirstlane(tid >> 6);
    const int G = gridDim.x, bx = blockIdx.x;
    const int vcu = (G % 8 == 0) ? (bx % 8) * (G / 8) + bx / 8 : bx;
    const int gw = bx * 8 + wave, NGW = G * 8;
    volatile LAS unsigned* MISC = (volatile LAS unsigned*)(lds + 131072 + 320);
    if (tid < 32) MISC[tid] = 0u;
    __syncthreads();
#define KARGS() ([]() __attribute__((always_inline)) { const __attribute__((address_space(4))) Args* p_ = (const __attribute__((address_space(4))) Args*)__builtin_amdgcn_kernarg_segment_ptr(); asm volatile("" : "+s"(p_)); return p_; }())
#define WS() ((unsigned char*)KARGS()->ws)
#define INP(i) ((const float*)KARGS()->in[i])
    const XcdBarrier xbar = xcd_barrier_post((unsigned*)WS(), MISC + 8);
#define GRID_BAR() xcd_barrier(xbar)
    if (PH(0)) {
    unsigned char* ws = WS();
    if (bx < 192) {
        const float *cvec = INP(1), *c_ctx = INP(3), *w_ada = INP(4), *b_ada = INP(5);
        float* MOD = (float*)(ws + WS_MOD);
        LAS float* S = (LAS float*)lds;
        LAS float* red = S + 17 * 1024;
        for (int i = tid; i < 17 * 1024; i += NTHR) { const float v = i < 16 * 1024 ? cvec[i] : c_ctx[i - 16 * 1024]; S[i] = v / (1.f + __expf(-v)); }
        __syncthreads();
        const int col = tid & 15, ks = tid >> 4, col0 = bx * 16;
        float acc[17];
#pragma unroll
        for (int r = 0; r < 17; ++r) acc[r] = 0.f;
        for (int k = ks; k < 1024; k += 32) { const float w = w_ada[(size_t)k * 3072 + col0 + col];
#pragma unroll
            for (int r = 0; r < 17; ++r) acc[r] += S[r * 1024 + k] * w; }
#pragma unroll
        for (int r = 0; r < 17; ++r) red[(ks * 17 + r) * 16 + col] = acc[r];
        __syncthreads();
        if (tid < 272) { const int r = tid >> 4, cc = tid & 15; float s = 0.f;
            for (int k2 = 0; k2 < 32; ++k2) s += red[(k2 * 17 + r) * 16 + cc];
            MOD[r * 3072 + col0 + cc] = s + b_ada[col0 + cc]; }
        __syncthreads();
    }
    {
        LAS float* scr = (LAS float*)(lds + wave * 16384);
        constexpr int I_IN = 16 * 61, I_Q = 4 * 24, I_KV = 2 * 32, I_F = 8 * 16, I_O = 16 * 32, NITEMS = I_IN + I_Q + I_KV + I_F + I_O;
        for (int it = gw; it < NITEMS; it += NGW) {
            int r = it;
            if (r < I_IN) { const int kb = r / 61, nb = r % 61; transpose_item(INP(6), 1024, 1952, (bf16_t*)(ws + WS_WIN), 64 * kb, 32 * nb, win_drow(32 * nb), nullptr, scr, lane); continue; } r -= I_IN;
            if (r < I_Q) { const int kb = r / 24, nb = r % 24, hh = nb / 3, part = nb % 3; const int dr = part < 2 ? hh * 64 + part * 32 : 512 + hh * 32;
                transpose_item(INP(9), 256, 768, (bf16_t*)(ws + WS_WQ), 64 * kb, 32 * nb, dr, INP(8), scr, lane); continue; } r -= I_Q;
            if (r < I_KV) { const int kb = r / 32, nb = r % 32, hh = nb / 4, part = nb % 4; const int dr = part < 2 ? hh * 64 + part * 32 : 512 + hh * 64 + (part - 2) * 32;
                transpose_item(INP(11), 128, 1024, (bf16_t*)(ws + WS_WKV), 64 * kb, 32 * nb, dr, INP(10), scr, lane); continue; } r -= I_KV;
            if (r < I_F) { const int kb = r / 16, nb = r % 16; transpose_item(INP(12), 512, 512, (bf16_t*)(ws + WS_WF), 64 * kb, 32 * nb, 32 * nb, nullptr, scr, lane); continue; } r -= I_F;
            { const int kb = r / 32, nb = r % 32; transpose_item(INP(14), 1024, 1024, (bf16_t*)(ws + WS_WO), 64 * kb, 32 * nb, 32 * nb, nullptr, scr, lane); }
        }
    }
    {
        float* ropeC = (float*)(ws + WS_ROPEC); float* ropeS = (float*)(ws + WS_ROPES);
        float* TWC = (float*)(ws + WS_TWC); float* TWS = (float*)(ws + WS_TWS); float* BIN2 = (float*)(ws + WS_BIN2);
        bf16_t *FcT = (bf16_t*)(ws + WS_FC), *G1 = (bf16_t*)(ws + WS_G1), *G2 = (bf16_t*)(ws + WS_G2), *WinT = (bf16_t*)(ws + WS_WIN);
        const float* b_in = INP(7);
        const int gt = bx * NTHR + tid, NT_ = G * NTHR;
        const double INV2PI = 0.15915494309189535;
        for (int i = gt; i < 4096 * 16; i += NT_) { const int pos = i >> 4, aa = i & 15; const int comp = aa < 8 ? (pos >> 6) : (pos & 63); const int fi = aa & 7;
            const double invf = fi == 0 ? 1.0 : fi == 1 ? 0.31622776601683794 : fi == 2 ? 0.1 : fi == 3 ? 0.031622776601683794 : fi == 4 ? 0.01 : fi == 5 ? 0.0031622776601683794 : fi == 6 ? 0.001 : 0.00031622776601683794;
            const double rev = (double)comp * invf * INV2PI; ropeC[i] = cos_rev(rev); ropeS[i] = sin_rev(rev); }
        for (int i = gt; i < 4096; i += NT_) { const int d = i >> 6, b = i & 63; const double rev = (double)((b * d) & 4095) / 4096.0; TWC[i] = cos_rev(rev); TWS[i] = sin_rev(rev); }
        for (int i = gt; i < 256 * 128; i += NT_) { const int r = i >> 7, kk = i & 127;
            { const int part = r >> 7, mc = r & 127; const double rev = (double)((kk * mc) & 127) / 128.0; const float v = part == 0 ? cos_rev(rev) : -sin_rev(rev); FcT[i] = (bf16_t)(cvtpk(v, 0.f) & 0xffffu); }
            { const int ai = r >> 7, q = r & 127, part = kk >> 6, aa = kk & 63; float v = 0.f;
              if (q < 64) { const double rev = (double)((aa * q) & 63) / 64.0; v = ai == 0 ? (part == 0 ? cos_rev(rev) : sin_rev(rev)) : (part == 0 ? -sin_rev(rev) : cos_rev(rev)); }
              G1[i] = (bf16_t)(cvtpk(v, 0.f) & 0xffffu); }
            { const int part = kk >> 6, bb = kk & 63; float v = 0.f;
              if (r < 64) { const double rev = (double)((bb * r) & 63) / 64.0; v = (part == 0 ? cos_rev(rev) : sin_rev(rev)) * FNORM; }
              G2[i] = (bf16_t)(cvtpk(v, 0.f) & 0xffffu); } }
        for (int i = gt; i < 2048; i += NT_) { float v = 0.f;
            if (i < 416) v = b_in[i]; else if (i >= 512 && i < 1024) v = b_in[416 + (i - 512)]; else if (i >= 1024 && i < 1536) v = b_in[928 + (i - 1024)]; else if (i >= 1536) v = b_in[1440 + (i - 1536)];
            BIN2[i] = v; }
        for (int i = gt; i < 96 * 1024 / 8; i += NT_) *(u32x4*)(WinT + (size_t)416 * 1024 + (size_t)i * 8) = (u32x4){0, 0, 0, 0};
    }
    }
    grid.sync();

    if (PH(1)) {
    unsigned char* ws = WS(); const float *x = INP(0), *ctx = INP(2);
    const float* MOD = (const float*)(ws + WS_MOD); bf16_t* XN = (bf16_t*)(ws + WS_XN);
    for (int m = gw; m < NROW; m += NGW) {
        const float* src = m < NLAT ? x + (size_t)m * DM : ctx + (size_t)(m - NLAT) * DM;
        const float* mod = MOD + (size_t)(m < NLAT ? (m >> 12) : 16) * 3072;
        const f32x4* xr = (const f32x4*)src + lane;
        f32x4 v[4]; float s = 0.f;
#pragma unroll
        for (int j = 0; j < 4; ++j) { v[j] = xr[64 * j]; s += (v[j][0] + v[j][1]) + (v[j][2] + v[j][3]); }
        const float mean = wave_sum(s) * (1.f / DM); float s2 = 0.f;
#pragma unroll
        for (int j = 0; j < 4; ++j) { v[j] = v[j] - mean; s2 += (v[j][0] * v[j][0] + v[j][1] * v[j][1]) + (v[j][2] * v[j][2] + v[j][3] * v[j][3]); }
        const float rstd = 1.f / sqrtf(wave_sum(s2) * (1.f / DM) + LN_EPS);
        uint2* o8 = (uint2*)(XN + (size_t)m * DM) + lane;
#pragma unroll
        for (int j = 0; j < 4; ++j) { const f32x4 sh = ((const f32x4*)mod)[lane + 64 * j], sc = ((const f32x4*)(mod + 1024))[lane + 64 * j];
            const f32x4 hv = v[j] * rstd * (sc + 1.f) + sh; uint2 w; w.x = cvtpk(hv[0], hv[1]); w.y = cvtpk(hv[2], hv[3]); o8[64 * j] = w; }
    }
    }
    GRID_BAR();

    if (PH(2)) {
        unsigned char* ws = WS();
        pg8::ProbRM P{(const bf16_t*)(ws + WS_XN), (const bf16_t*)(ws + WS_WIN), 1024, 1024, 16};
        pg8::GridOrder S; S.init(256, 8, G, bx, 16, 1);
        EpiIn E{ws};
        pg8::gemm_phase(lds, P, S, E);
    }
    GRID_BAR();

    if (PH(3)) {
        unsigned char* ws = WS();
        pg8::ProbRM P{(const bf16_t*)(ws + WS_QLAT), (const bf16_t*)(ws + WS_WQ), 256, 256, 4}; pg8::GridOrder S; S.init(256, 3, G, bx);
        EpiQ E{ws};
        pg8::gemm_phase(lds, P, S, E);
    }
    if (PH(4)) {
        unsigned char* ws = WS();
        pg8::ProbRM P{(const bf16_t*)(ws + WS_CKV), (const bf16_t*)(ws + WS_WKV), 128, 128, 2}; pg8::GridOrder S; S.init(272, 4, G, bx);
        EpiKV E{ws};
        pg8::gemm_phase(lds, P, S, E);
    }
    if (PH(5)) {
        unsigned char* ws = WS();
        pg8::ProbF0 P{(const bf16_t*)(ws + WS_FC), (const bf16_t*)(ws + WS_FIN), 2}; pg8::LinOrder S; S.init(1024, G, bx);
        EpiF0 E{ws};
        pg8::gemm_phase(lds, P, S, E);
    }
    GRID_BAR();

    if (PH(6)) {
        unsigned char* ws = WS();
        pg8::ProbRM P{(const bf16_t*)(ws + WS_G1), (const bf16_t*)(ws + WS_X), 128, 128, 2}; pg8::LinOrder S; S.init(2048, G, bx);
        EpiF1 E{ws};
        pg8::gemm_phase(lds, P, S, E);
    }
    GRID_BAR();

    if (PH(7)) {
        unsigned char* ws = WS();
        pg8::ProbRM P{(const bf16_t*)(ws + WS_G2), (const bf16_t*)(ws + WS_Y2), 128, 128, 2}; pg8::LinOrder S; S.init(2048, G, bx);
        EpiF2 E{ws};
        pg8::gemm_phase(lds, P, S, E);
    }
    GRID_BAR();

#ifndef NO_ATT
    if (PH(8)) {
    unsigned char* ws = WS();
    for (int i = 0;; ++i) { const int L = i * G + vcu; if (L >= 2048) break; const int bh = L >> 4, qb = L & 15;
        att::attn_unit<8>(bh >> 3, bh & 7, qb, (const bf16_t*)(ws + WS_Q), (const bf16_t*)(ws + WS_K), (const bf16_t*)(ws + WS_V), (const bf16_t*)(ws + WS_SGM), (bf16_t*)(ws + WS_YMIX), lds); }
    }
#else
    { bf16_t* YMIX = (bf16_t*)(WS() + WS_YMIX);
    for (int m = gw; m < NLAT; m += NGW) *(u32x4*)(YMIX + (size_t)m * 1024 + lane * 8) = (u32x4){0, 0, 0, 0}; }
#endif
    if (PH(9)) {
        unsigned char* ws = WS();
        pg8::ProbRM P{(const bf16_t*)(ws + WS_Z), (const bf16_t*)(ws + WS_WF), 512, 512, 8}; pg8::GridOrder S; S.init(256, 2, G, bx);
        EpiF3 E{ws, INP(13)};
        pg8::gemm_phase(lds, P, S, E);
    }
    GRID_BAR();

    if (PH(10)) {
        unsigned char* ws = WS();
        pg8::ProbRM P{(const bf16_t*)(ws + WS_YMIX), (const bf16_t*)(ws + WS_WO), 1024, 1024, 16}; pg8::GridOrder S; S.init(256, 4, G, bx);
        EpiOut E{ws, INP(15), INP(0), (float*)KARGS()->out};
        pg8::gemm_phase(lds, P, S, E);
    }
    GRID_BAR();

    if (PH(11)) {
    float* outp = (float*)KARGS()->out; const float *post_g = INP(16), *post_b = INP(17);
    for (int m = gw; m < NLAT; m += NGW) {
        f32x4* xr = (f32x4*)(outp + (size_t)m * DM) + lane;
        f32x4 v[4]; float s = 0.f;
#pragma unroll
        for (int j = 0; j < 4; ++j) { v[j] = xr[64 * j]; s += (v[j][0] + v[j][1]) + (v[j][2] + v[j][3]); }
        const float mean = wave_sum(s) * (1.f / DM); float s2 = 0.f;
#pragma unroll
        for (int j = 0; j < 4; ++j) { v[j] = v[j] - mean; s2 += (v[j][0] * v[j][0] + v[j][1] * v[j][1]) + (v[j][2] * v[j][2] + v[j][3] * v[j][3]); }
        const float rstd = 1.f / sqrtf(wave_sum(s2) * (1.f / DM) + LN_EPS);
#pragma unroll
        for (int j = 0; j < 4; ++j) { const f32x4 gg = ((const f32x4*)post_g)[lane + 64 * j], b4 = ((const f32x4*)post_b)[lane + 64 * j]; xr[64 * j] = v[j] * rstd * gg + b4; }
    }
    }
}

extern "C" void kernel_launch(void* const* d_in, const int* in_sizes, int n_in, void* d_out, int out_size, void* d_ws, size_t ws_size, hipStream_t stream) {
    static int grid = 0;
    if (grid == 0) {
        if (n_in != 18 || out_size != NLAT * DM || ws_size < WS_END) { fprintf(stderr, "kernel_launch: unexpected shapes: n_in %d out %d ws %zu (need %zu)\n", n_in, out_size, ws_size, (size_t)WS_END); grid = -1; return; }
        int dev = 0, cus = 0, per_cu = 0;
        (void)hipGetDevice(&dev);
        (void)hipDeviceGetAttribute(&cus, hipDeviceAttributeMultiprocessorCount, dev);
        (void)hipFuncSetAttribute((const void*)mk_fwd, hipFuncAttributeMaxDynamicSharedMemorySize, LDS_BYTES);
        (void)hipOccupancyMaxActiveBlocksPerMultiprocessor(&per_cu, (const void*)mk_fwd, NTHR, LDS_BYTES);
        if (per_cu < 1) { fprintf(stderr, "kernel_launch: occupancy query reports %d blocks/CU\n", per_cu); grid = -1; return; }
        grid = cus;
    }
    if (grid < 0) return;
    (void)hipMemsetAsync(d_ws, 0, 65536, stream);
    Args a{};
    for (int i = 0; i < 18; ++i) a.in[i] = (const float*)d_in[i];
    a.out = (float*)d_out; a.ws = (unsigned char*)d_ws;
    void* args[] = {&a};
    hipError_t e = hipLaunchCooperativeKernel((const void*)mk_fwd, dim3(grid), dim3(NTHR), args, LDS_BYTES, stream);
    if (e != hipSuccess) fprintf(stderr, "cooperative launch failed: %s (grid %d)\n", hipGetErrorString(e), grid);
}
```
